# Optimizing an MI355X kernel written in HIP

```python
import math
import jax, jax.numpy as jnp
from jax import lax
import numpy as np

D_MODEL = 1024
BATCH = 8
SEQ = 2048
DEPTH = 1

GRID_W = 64
NA_HEADS = 8
NA_HEAD_DIM = 64
NA_WIDTH = NA_HEADS * NA_HEAD_DIM
NA_WIN_ROWS = 8
NA_WIN_COLS = 16
DIFF_HEADS = 4
DIFF_HEAD_DIM = 64
DIFF_V_DIM = 2 * DIFF_HEAD_DIM
DIFF_QK = DIFF_HEADS * 2 * DIFF_HEAD_DIM
DIFF_WIDTH = DIFF_HEADS * DIFF_V_DIM
MIX_WIDTH = NA_WIDTH + DIFF_WIDTH
IN_WIDTH = 3 * NA_WIDTH + 2 * DIFF_QK + DIFF_WIDTH
IN_SPLITS = (NA_WIDTH, 2 * NA_WIDTH, 3 * NA_WIDTH, 3 * NA_WIDTH + DIFF_QK, 3 * NA_WIDTH + 2 * DIFF_QK)
ATTN_BLOCK = 128
T5_BUCKETS = 32
T5_MAX_DIST = 128
PEER_HEADS = 8
PEER_NKEYS = 128
PEER_N = PEER_NKEYS * PEER_NKEYS
PEER_DKEY = 256
PEER_TOPK = 16
PEER_CHUNK = 128
LN_EPS = 1e-5
DN_ALPHA = (2.0 * DEPTH) ** 0.25
DN_BETA = (8.0 * DEPTH) ** -0.25
NEG_BIG = -1e30

kernel_name = "hybrid_natten_diffattn_peer_encoder"


def _layer_norm(x, gain=None, bias=None):
    xf = x.astype(jnp.float32)
    mu = jnp.mean(xf, axis=-1, keepdims=True)
    var = jnp.mean(jnp.square(xf - mu), axis=-1, keepdims=True)
    y = (xf - mu) * lax.rsqrt(var + LN_EPS)
    if gain is not None:
        y = y * gain.astype(jnp.float32) + bias.astype(jnp.float32)
    return y.astype(x.dtype)


def _t5_bucket(rel):
    nb = T5_BUCKETS // 2
    max_exact = nb // 2
    bucket = jnp.where(rel > 0, nb, 0)
    n = jnp.abs(rel)
    nf = jnp.maximum(n, 1).astype(jnp.float32)
    large = max_exact + (jnp.log(nf / max_exact) / math.log(T5_MAX_DIST / max_exact)
                         * (nb - max_exact)).astype(jnp.int32)
    large = jnp.minimum(large, nb - 1)
    return bucket + jnp.where(n < max_exact, n, large)


def _neighbourhood_attention(q, k, v, rpb):
    b, s, h, dh = q.shape
    rows = s // GRID_W
    kr = min(NA_WIN_ROWS, rows)
    kc = NA_WIN_COLS
    r = jnp.arange(rows)
    row_start = jnp.clip(r - kr // 2, 0, rows - kr)
    row_idx = row_start[:, None] + jnp.arange(kr)[None, :]
    col = jnp.arange(GRID_W)
    col_start = jnp.clip(col - kc // 2, 0, GRID_W - kc)
    col_valid = (col[None, :] >= col_start[:, None]) & (col[None, :] < col_start[:, None] + kc)
    row_off = row_idx - r[:, None] + (NA_WIN_ROWS - 1)
    col_off = jnp.clip(col[None, :] - col[:, None], -(kc - 1), kc - 1) + (NA_WIN_COLS - 1)
    bias = rpb[:, row_off[:, None, :, None], col_off[None, :, None, :]].astype(jnp.float32)
    bias = jnp.where(col_valid[None, None, :, None, :], bias, NEG_BIG)
    qg = q.reshape(b, rows, GRID_W, h, dh)
    kg = k.reshape(b, rows, GRID_W, h, dh)[:, row_idx]
    vg = v.reshape(b, rows, GRID_W, h, dh)[:, row_idx]
    logits = jnp.einsum('brqhd,brikhd->bhrqik', qg, kg,
                        preferred_element_type=jnp.float32) * (dh ** -0.5) + bias[None]
    p = jax.nn.softmax(logits.reshape(b, h, rows, GRID_W, kr * GRID_W), axis=-1)
    p = p.reshape(b, h, rows, GRID_W, kr, GRID_W).astype(v.dtype)
    o = jnp.einsum('bhrqik,brikhd->brqhd', p, vg)
    return o.reshape(b, s, h * dh)


def _diff_attention(q, k, v, t5_bias, lq1, lk1, lq2, lk2, subln_g, lambda_init):
    b, s, h, _, d = q.shape
    f32 = jnp.float32
    lam = (jnp.exp(jnp.sum(lq1.astype(f32) * lk1.astype(f32)))
           - jnp.exp(jnp.sum(lq2.astype(f32) * lk2.astype(f32))) + lambda_init)
    nblk = s // ATTN_BLOCK
    qb = jnp.moveaxis(q.reshape(b, nblk, ATTN_BLOCK, h, 2, d), 1, 0)
    kpos = jnp.arange(s)

    def block(args):
        qi, i = args
        qpos = i * ATTN_BLOCK + jnp.arange(ATTN_BLOCK)
        bucket = _t5_bucket(kpos[None, :] - qpos[:, None])
        bias = jnp.transpose(t5_bias[bucket].astype(f32), (2, 0, 1))
        logits = jnp.einsum('bqhmd,bkhmd->bhmqk', qi, k,
                            preferred_element_type=f32) * (d ** -0.5) + bias[None, :, None]
        p = jax.nn.softmax(logits, axis=-1)
        w = (p[:, :, 0] - lam * p[:, :, 1]).astype(v.dtype)
        return jnp.einsum('bhqk,bkhe->bqhe', w, v)

    o = lax.map(block, (qb, jnp.arange(nblk)))
    o = jnp.moveaxis(o, 0, 1).reshape(b, s, h, 2 * d).astype(f32)
    o = o * lax.rsqrt(jnp.mean(o * o, axis=-1, keepdims=True) + LN_EPS) * subln_g.astype(f32)
    return (o * (1.0 - lambda_init)).astype(v.dtype).reshape(b, s, h * 2 * d)


def _peer(u, w_query, sub_keys, expert_down, expert_up):
    b, s, dm = u.shape
    tokens = u.reshape(-1, PEER_CHUNK, dm)

    def chunk(xc):
        qc = (xc @ w_query).reshape(PEER_CHUNK, PEER_HEADS, 2, PEER_DKEY // 2)
        s_half = jnp.einsum('chpk,pnk->chpn', qc, sub_keys,
                            preferred_element_type=jnp.float32)
        top_s, top_i = lax.top_k(s_half, PEER_TOPK)
        cand_s = (top_s[:, :, 0, :, None] + top_s[:, :, 1, None, :]).reshape(PEER_CHUNK, PEER_HEADS, -1)
        cand_i = (top_i[:, :, 0, :, None] * PEER_NKEYS + top_i[:, :, 1, None, :]).reshape(PEER_CHUNK, PEER_HEADS, -1)
        best_s, best_j = lax.top_k(cand_s, PEER_TOPK)
        expert = jnp.take_along_axis(cand_i, best_j, axis=-1)
        g = jax.nn.softmax(best_s, axis=-1)
        u_e = expert_down[expert]
        act = jax.nn.gelu(jnp.einsum('chkd,cd->chk', u_e, xc,
                                     preferred_element_type=jnp.float32), approximate=False)
        v_e = expert_up[expert]
        return jnp.einsum('chk,chkd->cd', (g * act).astype(xc.dtype), v_e)

    out = lax.map(chunk, tokens)
    return out.reshape(b, s, dm)


def setup_inputs(seed: int = 0) -> dict:
    key = jax.random.key(seed)
    ks = jax.random.split(key, 24)
    nrm = jax.random.normal
    f32 = jnp.float32
    d = D_MODEL
    return {
        "x": nrm(ks[0], (BATCH, SEQ, d), f32),
        "c": nrm(ks[1], (BATCH, d), f32),
        "w_ada": nrm(ks[2], (DEPTH, d, 6 * d), f32) * (0.2 * d ** -0.5),
        "b_ada": nrm(ks[3], (DEPTH, 6 * d), f32) * 0.01,
        "w_in": nrm(ks[4], (DEPTH, d, IN_WIDTH), f32) * d ** -0.5,
        "w_out": nrm(ks[5], (DEPTH, MIX_WIDTH, d), f32) * (MIX_WIDTH ** -0.5 * DN_BETA),
        "na_rpb": nrm(ks[6], (DEPTH, NA_HEADS, 2 * NA_WIN_ROWS - 1, 2 * NA_WIN_COLS - 1), f32) * 0.1,
        "t5_bias": nrm(ks[7], (T5_BUCKETS, DIFF_HEADS), f32) * 0.1,
        "lambda_q1": nrm(ks[8], (DEPTH, DIFF_HEAD_DIM), f32) * 0.1,
        "lambda_k1": nrm(ks[9], (DEPTH, DIFF_HEAD_DIM), f32) * 0.1,
        "lambda_q2": nrm(ks[10], (DEPTH, DIFF_HEAD_DIM), f32) * 0.1,
        "lambda_k2": nrm(ks[11], (DEPTH, DIFF_HEAD_DIM), f32) * 0.1,
        "diff_subln": 1.0 + 0.02 * nrm(ks[12], (DEPTH, DIFF_V_DIM), f32),
        "ln1_g": 1.0 + 0.02 * nrm(ks[13], (DEPTH, d), f32),
        "ln1_b": 0.02 * nrm(ks[14], (DEPTH, d), f32),
        "w_query": nrm(ks[15], (DEPTH, d, PEER_HEADS * PEER_DKEY), f32) * d ** -0.5,
        "sub_keys": nrm(ks[16], (DEPTH, 2, PEER_NKEYS, PEER_DKEY // 2), f32) * (PEER_DKEY // 2) ** -0.5,
        "expert_down": nrm(ks[17], (DEPTH, PEER_N, d), f32) * d ** -0.5,
        "expert_up": nrm(ks[18], (DEPTH, PEER_N, d), f32) * DN_BETA,
        "ln2_g": 1.0 + 0.02 * nrm(ks[19], (DEPTH, d), f32),
        "ln2_b": 0.02 * nrm(ks[20], (DEPTH, d), f32),
    }


def reference(x, c, w_ada, b_ada, w_in, w_out, na_rpb, t5_bias, lambda_q1, lambda_k1,
              lambda_q2, lambda_k2, diff_subln, ln1_g, ln1_b, w_query, sub_keys,
              expert_down, expert_up, ln2_g, ln2_b):
    b, s, _ = x.shape
    for l in range(DEPTH):
        lambda_init = 0.8 - 0.6 * math.exp(-0.3 * l)
        mod = jnp.einsum('bd,de->be', jax.nn.silu(c), w_ada[l]) + b_ada[l]
        sh_a, sc_a, g_a, sh_f, sc_f, g_f = jnp.split(mod[:, None, :], 6, axis=-1)

        h = _layer_norm(x) * (1.0 + sc_a) + sh_a
        proj = h @ w_in[l]
        na_q, na_k, na_v, d_q, d_k, d_v = jnp.split(proj, IN_SPLITS, axis=-1)
        o_na = _neighbourhood_attention(
            na_q.reshape(b, s, NA_HEADS, NA_HEAD_DIM),
            na_k.reshape(b, s, NA_HEADS, NA_HEAD_DIM),
            na_v.reshape(b, s, NA_HEADS, NA_HEAD_DIM),
            na_rpb[l])
        o_diff = _diff_attention(
            d_q.reshape(b, s, DIFF_HEADS, 2, DIFF_HEAD_DIM),
            d_k.reshape(b, s, DIFF_HEADS, 2, DIFF_HEAD_DIM),
            d_v.reshape(b, s, DIFF_HEADS, DIFF_V_DIM),
            t5_bias, lambda_q1[l], lambda_k1[l], lambda_q2[l], lambda_k2[l],
            diff_subln[l], lambda_init)
        mix = jnp.concatenate([o_na, o_diff], axis=-1) @ w_out[l]
        x = _layer_norm(DN_ALPHA * x + (1.0 + g_a) * mix, ln1_g[l], ln1_b[l])

        h = _layer_norm(x) * (1.0 + sc_f) + sh_f
        f = _peer(h, w_query[l], sub_keys[l], expert_down[l], expert_up[l])
        x = _layer_norm(DN_ALPHA * x + (1.0 + g_f) * f, ln2_g[l], ln2_b[l])
    return x
```

```cpp
#include <hip/hip_runtime.h>
#include <hip/hip_bf16.h>
#include <cstdio>
#include <cstdint>
#include <cmath>
namespace pg8 {
#define PG8_LAS __attribute__((address_space(3)))
typedef unsigned short bf16_t;
typedef short bf16x8 __attribute__((ext_vector_type(8)));
typedef float f32x4 __attribute__((ext_vector_type(4)));
typedef unsigned u32x4 __attribute__((ext_vector_type(4)));
constexpr int BM = 256, BK = 64, HALF = 128, HTB = HALF * BK * 2  , STAGE_BYTES = 8 * HTB, NXCD = 8, WGM = 8;

__host__ __device__ __forceinline__ int lds_byte(int r, int c) { const int st = (r >> 4) * 2 + (c >> 5), rr = r & 15, cc = c & 31, ob = rr * 64 + cc * 2; return st * 1024 + (ob ^ (((ob >> 9) & 1) << 5)); }
__host__ __device__ __forceinline__ void stage_rc(int b, int& R, int& C) { const int st = b / 1024, sb = b % 1024, swz = sb ^ (((sb >> 9) & 1) << 5); R = (st >> 1) * 16 + swz / 64; C = (st & 1) * 32 + (swz % 64) / 2; }
__host__ __device__ __forceinline__ int perm32(int rho) { const int n = rho >> 4, i = rho & 15; return 8 * (i >> 2) + 4 * n + (i & 3); }

struct Unit { int pm, pn; };
struct Gemm { const bf16_t* A; const bf16_t* Bt; int M, N, K; };

struct StaticOrder {
    int nM, nN, nwg, G, c;
    __host__ __device__ void init(int M, int N, int G_, int c_) { nM = M / BM; nN = N / BM; nwg = nM * nN; G = G_; c = c_; }
    __host__ __device__ bool next(int i, Unit& u) const {
        const long L = (long)i * G + c; if (L >= nwg) return false;
        int wgid = (int)L; { const int q = nwg / NXCD, r = nwg % NXCD, xcd = wgid % NXCD, off = wgid / NXCD; wgid = (xcd < r ? xcd * (q + 1) : r * (q + 1) + (xcd - r) * q) + off; }
        const int nig = WGM * nN, gid = wgid / nig, fm = gid * WGM, gsz = (nM - fm) < WGM ? (nM - fm) : WGM;
        u.pm = fm + ((wgid % nig) % gsz); u.pn = (wgid % nig) / gsz; return true;
    }
    __device__ __forceinline__ void a_ready(const Unit&) const {}
    __device__ __forceinline__ void done(const Unit&) const {}
};

__device__ __forceinline__ unsigned cvt_pk_bf16(float lo, float hi) { unsigned r; asm volatile("v_cvt_pk_bf16_f32 %0, %1, %2" : "=v"(r) : "v"(lo), "v"(hi)); return r; }
typedef float f32x2 __attribute__((ext_vector_type(2)));
struct EpiBf16 {
    static constexpr bool PERM = true, AFTER_DRAIN = false;
    bf16_t* O; int ldc;
    __device__ __forceinline__ void operator()(const f32x4 (&acc)[2][2][4][2], const Unit& u, int wr, int wc, int fr, int fq) const {
        const int row0 = u.pm * BM + wr * 64 + fr; const int col0 = u.pn * BM + wc * 32 + 8 * fq;
#pragma unroll
        for (int ai = 0; ai < 2; ++ai)
#pragma unroll
            for (int m = 0; m < 4; ++m) { bf16_t* rowp = O + (size_t)(row0 + ai * HALF + m * 16) * ldc + col0;
#pragma unroll
                for (int bj = 0; bj < 2; ++bj) { const f32x4 v0 = acc[ai][bj][m][0], v1 = acc[ai][bj][m][1];
                    u32x4 w; w.x = cvt_pk_bf16(v0[0], v0[1]); w.y = cvt_pk_bf16(v0[2], v0[3]); w.z = cvt_pk_bf16(v1[0], v1[1]); w.w = cvt_pk_bf16(v1[2], v1[3]);
                    *(u32x4*)(rowp + bj * HALF) = w; } }
    }
};
struct EpiF32 {
    static constexpr bool PERM = false, AFTER_DRAIN = false;
    float* O; int ldc;
    __device__ __forceinline__ void operator()(const f32x4 (&acc)[2][2][4][2], const Unit& u, int wr, int wc, int fr, int fq) const {
        const int row0 = u.pm * BM + wr * 64 + fr; const int col0 = u.pn * BM + wc * 32 + 4 * fq;
#pragma unroll
        for (int ai = 0; ai < 2; ++ai)
#pragma unroll
            for (int m = 0; m < 4; ++m) { float* rowp = O + (size_t)(row0 + ai * HALF + m * 16) * ldc + col0;
#pragma unroll
                for (int bj = 0; bj < 2; ++bj)
#pragma unroll
                    for (int n = 0; n < 2; ++n) *(f32x4*)(rowp + bj * HALF + n * 16) = acc[ai][bj][m][n]; }
    }
};
struct EpiY {
    static constexpr bool PERM = false, AFTER_DRAIN = false;
    const float* X; const float* gate;   int gstride; float* Y; float alpha;
    __device__ __forceinline__ void operator()(const f32x4 (&acc)[2][2][4][2], const Unit& u, int wr, int wc, int fr, int fq) const {
        const int row0 = u.pm * BM + wr * 64 + fr; const int col0 = u.pn * BM + wc * 32 + 4 * fq;
        const float* gp = gate + (size_t)((u.pm * BM) >> 11) * gstride + col0;
        f32x4 gv[2][2];
#pragma unroll
        for (int bj = 0; bj < 2; ++bj)
#pragma unroll
            for (int n = 0; n < 2; ++n) gv[bj][n] = *(const f32x4*)(gp + bj * HALF + n * 16) + 1.0f;
#pragma unroll
        for (int ai = 0; ai < 2; ++ai)
#pragma unroll
            for (int m = 0; m < 4; ++m) { const size_t off = (size_t)(row0 + ai * HALF + m * 16) * 1024 + col0;
#pragma unroll
                for (int bj = 0; bj < 2; ++bj)
#pragma unroll
                    for (int n = 0; n < 2; ++n) { const f32x4 xv = *(const f32x4*)(X + off + bj * HALF + n * 16);
                        *(f32x4*)(Y + off + bj * HALF + n * 16) = xv * alpha + gv[bj][n] * acc[ai][bj][m][n]; } }
    }
};

template <class Epi, class Sched, bool ALIGN_EPI = false, bool SP2 = false>
__device__ __forceinline__ void gemm_phase(PG8_LAS unsigned char* lds, const Gemm g, const Sched& S, const Epi& E) {
    const int tid = threadIdx.x, wid = __builtin_amdgcn_readfirstlane(tid >> 6), lane = tid & 63, wr = wid >> 2, wc = wid & 3, fr = lane & 15, fq = lane >> 4;
    const int K = g.K, nt = K / BK;
    unsigned voffA[2], voffB[2];
#pragma unroll
    for (int i = 0; i < 2; ++i) { int R, C; stage_rc(tid * 16 + i * 8192, R, C); const int Rb = Epi::PERM ? ((R & ~31) + perm32(R & 31)) : R;
        voffA[i] = (unsigned)(R * K + C) * 2u; voffB[i] = (unsigned)(Rb * K + C) * 2u; }
    const size_t kstep = (size_t)(BK * 2);
    const size_t hstep = (size_t)HALF * K * 2;
    const size_t tstep = 2 * hstep;
    const unsigned ldsw = (unsigned)wid * 1024u;
    const int aoff = lds_byte(wr * 64 + fr, fq * 8), boff = lds_byte(wc * 32 + fr, fq * 8);
#define PG8_SA(b, h) (((b) * 2 + (h)) * HTB)
#define PG8_SB(b, h) ((4 + (b) * 2 + (h)) * HTB)
#define PG8_STAGE(bufoff, gbase, voff) do { _Pragma("unroll") for (int _i = 0; _i < 2; ++_i) \
        __builtin_amdgcn_global_load_lds((const unsigned*)((const char*)(gbase) + (voff)[_i]), (PG8_LAS unsigned*)(lds + (bufoff) + ldsw + _i * 8192), 16, 0, 0); } while (0)
#define PG8_LDA(dst, b, h) do { _Pragma("unroll") for (int m = 0; m < 4; ++m) _Pragma("unroll") for (int k = 0; k < 2; ++k) dst[m][k] = *(const PG8_LAS bf16x8*)(lds + PG8_SA(b, h) + aoff + m * 2048 + k * 1024); } while (0)
#define PG8_LDB(dst, b, h) do { _Pragma("unroll") for (int n = 0; n < 2; ++n) _Pragma("unroll") for (int k = 0; k < 2; ++k) dst[n][k] = *(const PG8_LAS bf16x8*)(lds + PG8_SB(b, h) + boff + n * 2048 + k * 1024); } while (0)
#define PG8_MMA(ai, bj, At, Bt) do { __builtin_amdgcn_s_setprio(1); _Pragma("unroll") for (int m = 0; m < 4; ++m) _Pragma("unroll") for (int n = 0; n < 2; ++n) _Pragma("unroll") for (int k = 0; k < 2; ++k) \
        acc[ai][bj][m][n] = __builtin_amdgcn_mfma_f32_16x16x32_bf16(Bt[n][k], At[m][k], acc[ai][bj][m][n], 0, 0, 0); __builtin_amdgcn_s_setprio(0); } while (0)
#define PG8_WAIT_V(n) asm volatile("s_waitcnt vmcnt(" #n ")" ::: "memory")
#define PG8_WAIT_L(n) asm volatile("s_waitcnt lgkmcnt(" #n ")" ::: "memory")
#define PG8_BAR __builtin_amdgcn_s_barrier()
#define PG8_SCHED __builtin_amdgcn_sched_barrier(0)
    Unit cur, nxt; int ui = 0;
    if (!S.next(0, cur)) return;
    f32x4 acc[2][2][4][2];
#pragma unroll
    for (int a = 0; a < 2; ++a)
#pragma unroll
        for (int b = 0; b < 2; ++b)
#pragma unroll
            for (int m = 0; m < 4; ++m)
#pragma unroll
                for (int n = 0; n < 2; ++n) acc[a][b][m][n] = (f32x4){0.f, 0.f, 0.f, 0.f};
    bf16x8 At[4][2], B0[2][2], B1[2][2];
    const char* cA = (const char*)g.A + (size_t)cur.pm * tstep; const char* cB = (const char*)g.Bt + (size_t)cur.pn * tstep;
    S.a_ready(cur);
    if constexpr (SP2) {
        PG8_STAGE(PG8_SB(0, 0), cB, voffB); PG8_STAGE(PG8_SB(0, 1), cB + hstep, voffB); PG8_STAGE(PG8_SA(0, 0), cA, voffA); PG8_STAGE(PG8_SA(0, 1), cA + hstep, voffA);
        if (wr == 1) PG8_BAR;
        PG8_WAIT_V(2); PG8_BAR;
        PG8_STAGE(PG8_SB(1, 0), cB + kstep, voffB); PG8_STAGE(PG8_SA(1, 0), cA + kstep, voffA); PG8_STAGE(PG8_SB(1, 1), cB + hstep + kstep, voffB);
        PG8_WAIT_V(6); PG8_BAR;
    } else {
        PG8_STAGE(PG8_SB(0, 0), cB, voffB); PG8_STAGE(PG8_SA(0, 0), cA, voffA); PG8_STAGE(PG8_SB(0, 1), cB + hstep, voffB); PG8_STAGE(PG8_SA(0, 1), cA + hstep, voffA);
        if (wr == 1) PG8_BAR;
        PG8_WAIT_V(4); PG8_BAR;
        PG8_STAGE(PG8_SB(1, 0), cB + kstep, voffB); PG8_STAGE(PG8_SA(1, 0), cA + kstep, voffA); PG8_STAGE(PG8_SB(1, 1), cB + hstep + kstep, voffB);
        PG8_WAIT_V(6); PG8_BAR;
    }
    for (;;) {
        const bool has_next = S.next(ui + 1, nxt);
        const char* nA = has_next ? (const char*)g.A + (size_t)nxt.pm * tstep : cA; const char* nB = has_next ? (const char*)g.Bt + (size_t)nxt.pn * tstep : cB;
        for (int t = 0; t < nt; t += 2) {
            const bool last = (t == nt - 2);
            const char* a1 = cA + (size_t)(t + 1) * kstep;
            const char* a2 = last ? nA : cA + (size_t)(t + 2) * kstep; const char* b2 = last ? nB : cB + (size_t)(t + 2) * kstep;
            const char* a3 = a2 + kstep; const char* b3 = b2 + kstep;
            if (last && has_next) S.a_ready(nxt);
            if constexpr (SP2) {
            PG8_LDB(B0, 0, 0); PG8_LDB(B1, 0, 1); PG8_SCHED; PG8_LDA(At, 0, 0); PG8_STAGE(PG8_SA(1, 1), a1 + hstep, voffA);
            PG8_WAIT_V(8); PG8_WAIT_L(0); PG8_BAR; PG8_MMA(0, 0, At, B0); PG8_MMA(0, 1, At, B1); PG8_BAR; PG8_SCHED;
            PG8_LDA(At, 0, 1); PG8_STAGE(PG8_SB(0, 0), b2, voffB); PG8_STAGE(PG8_SB(0, 1), b2 + hstep, voffB); PG8_STAGE(PG8_SA(0, 0), a2, voffA);
            PG8_WAIT_V(8); PG8_WAIT_L(0); PG8_BAR; PG8_MMA(1, 0, At, B0); PG8_MMA(1, 1, At, B1); PG8_BAR; PG8_SCHED;
            PG8_LDB(B0, 1, 0); PG8_LDB(B1, 1, 1); PG8_SCHED; PG8_LDA(At, 1, 0); PG8_STAGE(PG8_SA(0, 1), a2 + hstep, voffA);
            PG8_WAIT_V(8); PG8_WAIT_L(0); PG8_BAR; PG8_MMA(0, 0, At, B0); PG8_MMA(0, 1, At, B1); PG8_BAR; PG8_SCHED;
            PG8_LDA(At, 1, 1); PG8_STAGE(PG8_SB(1, 0), b3, voffB); PG8_STAGE(PG8_SB(1, 1), b3 + hstep, voffB); PG8_STAGE(PG8_SA(1, 0), a3, voffA);
            PG8_WAIT_V(8); PG8_WAIT_L(0); PG8_BAR; PG8_MMA(1, 0, At, B0); PG8_MMA(1, 1, At, B1); PG8_BAR; PG8_SCHED;
            } else {
            PG8_LDB(B0, 0, 0); PG8_SCHED; PG8_LDA(At, 0, 0); PG8_STAGE(PG8_SA(1, 1), a1 + hstep, voffA);
            PG8_WAIT_L(8); PG8_BAR; PG8_WAIT_L(0); PG8_MMA(0, 0, At, B0); PG8_BAR; PG8_SCHED;
            PG8_LDB(B1, 0, 1); PG8_STAGE(PG8_SB(0, 0), b2, voffB);
            PG8_BAR; PG8_WAIT_L(0); PG8_MMA(0, 1, At, B1); PG8_BAR;
            PG8_LDA(At, 0, 1); PG8_STAGE(PG8_SA(0, 0), a2, voffA);
            PG8_BAR; PG8_WAIT_L(0); PG8_MMA(1, 0, At, B0); PG8_BAR; PG8_SCHED;
            PG8_STAGE(PG8_SB(0, 1), b2 + hstep, voffB);
            PG8_WAIT_V(6); PG8_BAR; PG8_MMA(1, 1, At, B1); PG8_BAR;
            PG8_LDB(B0, 1, 0); PG8_SCHED; PG8_LDA(At, 1, 0); PG8_STAGE(PG8_SA(0, 1), a2 + hstep, voffA);
            PG8_WAIT_L(8); PG8_BAR; PG8_WAIT_L(0); PG8_MMA(0, 0, At, B0); PG8_BAR; PG8_SCHED;
            PG8_LDB(B1, 1, 1); PG8_STAGE(PG8_SB(1, 0), b3, voffB);
            PG8_BAR; PG8_WAIT_L(0); PG8_MMA(0, 1, At, B1); PG8_BAR;
            PG8_LDA(At, 1, 1); PG8_STAGE(PG8_SA(1, 0), a3, voffA);
            PG8_BAR; PG8_WAIT_L(0); PG8_MMA(1, 0, At, B0); PG8_BAR; PG8_SCHED;
            PG8_STAGE(PG8_SB(1, 1), b3 + hstep, voffB);
            PG8_WAIT_V(6); PG8_BAR; PG8_MMA(1, 1, At, B1); PG8_BAR;
            }
        }
        if constexpr (ALIGN_EPI) { if (wr == 0) PG8_BAR; }
        if constexpr (!Epi::AFTER_DRAIN) { E(acc, cur, wr, wc, fr, fq); S.done(cur); }
        if (!has_next) break;
#pragma unroll
        for (int a = 0; a < 2; ++a)
#pragma unroll
            for (int b = 0; b < 2; ++b)
#pragma unroll
                for (int m = 0; m < 4; ++m)
#pragma unroll
                    for (int n = 0; n < 2; ++n) acc[a][b][m][n] = (f32x4){0.f, 0.f, 0.f, 0.f};
        cur = nxt; cA = nA; cB = nB; ++ui;
        if constexpr (ALIGN_EPI) { if (wr == 1) PG8_BAR; }
    }
    PG8_WAIT_V(0);
    if constexpr (!ALIGN_EPI) { if (wr == 0) PG8_BAR; }
    PG8_BAR;
    if constexpr (Epi::AFTER_DRAIN) { E.fused(acc, cur, wr, wc, fr, fq, lds, wid, lane); S.done(cur); }
#undef PG8_SA
#undef PG8_SB
#undef PG8_STAGE
#undef PG8_LDA
#undef PG8_LDB
#undef PG8_MMA
#undef PG8_WAIT_V
#undef PG8_WAIT_L
#undef PG8_BAR
#undef PG8_SCHED
}
}
#define GAS __attribute__((address_space(1)))
#define LAS __attribute__((address_space(3)))
typedef unsigned short bf16;
typedef unsigned v4u __attribute__((ext_vector_type(4)));
typedef float f32x4 __attribute__((ext_vector_type(4)));
typedef short bf16x8 __attribute__((ext_vector_type(8)));
typedef GAS unsigned gu32;
typedef GAS unsigned long long gu64;
#define RLX_AGENT __ATOMIC_RELAXED, __HIP_MEMORY_SCOPE_AGENT
#define LDS_WAIT() asm volatile("s_waitcnt lgkmcnt(0)" ::: "memory")
#define VM_WAIT() asm volatile("s_waitcnt vmcnt(0)" ::: "memory")
__device__ __forceinline__ unsigned long long rt() { return __builtin_amdgcn_s_memrealtime(); }
__device__ __forceinline__ unsigned f2bf(float f) { unsigned u = __builtin_bit_cast(unsigned, f); return (u + 0x7fffu + ((u >> 16) & 1u)) >> 16; }
__device__ __forceinline__ unsigned pk2(float lo, float hi) { return f2bf(lo) | (f2bf(hi) << 16); }

#define XB_TMO      128
#define XB_XCNT(j)  (256  + 64 * (j))
#define XB_XSUB(j)  (1280 + 64 * (j))
#define XB_XGEN(j)  (2304 + 64 * (j))
#define XB_TOP      3328
#define XB_TOPGEN   3392
#define XCD_BAR_WORDS 3456
#define XB_SPIN_CAP (1u << 18)

__device__ __forceinline__ unsigned xb_ld(unsigned* p)              { return __hip_atomic_load(p, __ATOMIC_RELAXED, __HIP_MEMORY_SCOPE_AGENT); }
__device__ __forceinline__ unsigned xb_add(unsigned* p, unsigned v) { return __hip_atomic_fetch_add(p, v, __ATOMIC_RELAXED, __HIP_MEMORY_SCOPE_AGENT); }
__device__ __forceinline__ unsigned xb_xcc_id() { return (unsigned)__builtin_amdgcn_s_getreg((3 << 11) | 20) & 0xFu; }
#define XB_SPIN(cond, bar) do { unsigned _sp = 0; while (cond) { __builtin_amdgcn_s_sleep(1); \
    if ((++_sp & 255u) == 0u) { if (xb_ld(&(bar)[XB_TMO])) break; if (_sp > XB_SPIN_CAP) { atomicAdd(&(bar)[XB_TMO], 1u); break; } } } } while (0)

struct XcdBarrier {
    unsigned* bar; unsigned x;
    volatile LAS unsigned* st;
};

__device__ __forceinline__ XcdBarrier xcd_barrier_post(unsigned* bar, volatile LAS unsigned* st) {
    XcdBarrier b; b.bar = bar; b.x = xb_xcc_id(); b.st = st;
    if (threadIdx.x == 0) (void)xb_add(&bar[XB_XCNT(b.x)], 1u);
    return b;
}
__device__ __forceinline__ void xcd_barrier_complete(unsigned* bar, unsigned x, unsigned& nloc, unsigned& nx) {
    const unsigned G = gridDim.x * gridDim.y * gridDim.z;
    unsigned sum, cnt, mine, sp = 0u;
    for (;;) {
        sum = 0u; cnt = 0u; mine = 0u;
#pragma unroll
        for (unsigned j = 0; j < 16; ++j) { const unsigned c = xb_ld(&bar[XB_XCNT(j)]); sum += c; cnt += (c > 0u) ? 1u : 0u; mine = (j == x) ? c : mine; }
        if (sum == G) break;
        __builtin_amdgcn_s_sleep(1);
        if ((++sp & 255u) == 0u) { if (xb_ld(&bar[XB_TMO])) break; if (sp > XB_SPIN_CAP) { atomicAdd(&bar[XB_TMO], 1u); break; } }
    }
    nloc = mine > 0u ? mine : 1u; nx = cnt > 0u ? cnt : 1u;
}

__device__ __forceinline__ void xcd_barrier(const XcdBarrier& b) {
    asm volatile("s_waitcnt vmcnt(0)" ::: "memory");
    __syncthreads();
    if (threadIdx.x == 0) {
        unsigned* bar = b.bar;
        __builtin_amdgcn_s_waitcnt(0);
        unsigned nloc = b.st[0], nx = b.st[1];
        if (nloc == 0u) { xcd_barrier_complete(bar, b.x, nloc, nx); b.st[0] = nloc; b.st[1] = nx; }
        const unsigned old = xb_add(&bar[XB_XSUB(b.x)], 1u);
        const unsigned gen = old / nloc;
        if (old + 1u == (gen + 1u) * nloc) {
            __builtin_amdgcn_fence(__ATOMIC_RELEASE, "agent");
            asm volatile("s_waitcnt vmcnt(0)" ::: "memory");
            const unsigned og = xb_add(&bar[XB_TOP], 1u);
            const unsigned tg = og / nx;
            if (og + 1u == (tg + 1u) * nx) xb_add(&bar[XB_TOPGEN], 1u);
            else XB_SPIN(xb_ld(&bar[XB_TOPGEN]) == tg, bar);
            __builtin_amdgcn_fence(__ATOMIC_ACQUIRE, "agent");
            xb_add(&bar[XB_XGEN(b.x)], 1u);
            asm volatile("s_waitcnt vmcnt(0)" ::: "memory");
        } else {
            XB_SPIN(xb_ld(&bar[XB_XGEN(b.x)]) == gen, bar);
            __builtin_amdgcn_fence(__ATOMIC_ACQUIRE, "agent");
            asm volatile("s_waitcnt vmcnt(0)" ::: "memory");
        }
    }
    __syncthreads();
}

#ifndef MK_N_LAUNCHES
#define MK_N_LAUNCHES 1
#endif
constexpr int N_PHASES = 8;
constexpr int N_LAUNCHES = MK_N_LAUNCHES;
constexpr int NWAVES = 8;
constexpr int NB = 8, SEQ = 2048, DM = 1024, MTOK = NB * SEQ;
constexpr float LN_EPS = 1e-5f;
constexpr float DN_ALPHA = 1.189207115002721f;
constexpr float LOG2E = 1.4426950408889634f;
constexpr float QSCALE = 0.125f * LOG2E;
constexpr float LAMBDA_INIT = 0.2f;
constexpr int MODS = 6 * DM;

constexpr size_t MiB = 1u << 20;
constexpr size_t WS_CTL = 0, CTL_ZERO_BYTES = 65536;
constexpr size_t WS_MOD = 1 * MiB;
constexpr size_t WS_WQK = 2 * MiB, WS_WV = 6 * MiB, WS_WO = 8 * MiB, WS_WC = 10 * MiB;
constexpr size_t WS_ED = 16 * MiB, WS_EU = 48 * MiB, WS_H2 = 80 * MiB;
constexpr size_t WS_XN = 112 * MiB, WS_QK = 144 * MiB, WS_VT = 208 * MiB;
constexpr size_t WS_CC = 112 * MiB, WS_Y = 144 * MiB, WS_ST = 112 * MiB;
constexpr size_t WS_END = 240 * MiB;
constexpr int CW_BAR = 1024;

constexpr int RING_BYTES = 131072;
constexpr int LDSCTL_OFF = RING_BYTES, MISC_OFF = LDSCTL_OFF + 320;
constexpr int LDS_BYTES = 147456;

typedef float f32x16 __attribute__((ext_vector_type(16)));
typedef float f32x2v __attribute__((ext_vector_type(2)));
typedef unsigned u32x2 __attribute__((ext_vector_type(2)));
typedef __bf16 bf16x2_t __attribute__((ext_vector_type(2)));

__device__ __forceinline__ unsigned cvtpk(float lo, float hi) { f32x2v v = {lo, hi}; bf16x2_t b = __builtin_convertvector(v, bf16x2_t); return __builtin_bit_cast(unsigned, b); }
__device__ __forceinline__ float bf_lo(unsigned w) { return __builtin_bit_cast(float, w << 16); }
__device__ __forceinline__ float bf_hi(unsigned w) { return __builtin_bit_cast(float, w & 0xffff0000u); }
__device__ __forceinline__ float wave_sum(float v) {
#pragma unroll
    for (int o = 1; o < 64; o <<= 1) v += __shfl_xor(v, o);
    return v;
}
__device__ __forceinline__ float dot2bf(unsigned w, unsigned x, float acc) { return __builtin_amdgcn_fdot2_f32_bf16(__builtin_bit_cast(bf16x2_t, w), __builtin_bit_cast(bf16x2_t, x), acc, false); }

__device__ __forceinline__ void phase_mod(const float* c, const float* w_ada, const float* b_ada, float* mod, unsigned char* lds, int tid, int lane, int wave) {
    float* sc = (float*)lds;
    float* red = (float*)(lds + 32768);
    bool did = false;
    for (int item = blockIdx.x; item < MODS / 64; item += gridDim.x) {
        if (!did) { for (int i = tid; i < NB * DM; i += 512) { const float v = c[i]; sc[i] = v / (1.f + __expf(-v)); } __syncthreads(); did = true; }
        const int e0 = item * 64, cg = lane & 15, rs = lane >> 4;
        float acc[8][4];
#pragma unroll
        for (int b = 0; b < 8; ++b) { acc[b][0] = 0.f; acc[b][1] = 0.f; acc[b][2] = 0.f; acc[b][3] = 0.f; }
#pragma unroll 4
        for (int it = 0; it < 32; ++it) {
            const int d = wave * 128 + it * 4 + rs;
            const f32x4 wv = *(const f32x4*)(w_ada + (size_t)d * MODS + e0 + 4 * cg);
#pragma unroll
            for (int b = 0; b < 8; ++b) { const float s = sc[b * DM + d]; acc[b][0] += s * wv[0]; acc[b][1] += s * wv[1]; acc[b][2] += s * wv[2]; acc[b][3] += s * wv[3]; }
        }
#pragma unroll
        for (int b = 0; b < 8; ++b)
#pragma unroll
            for (int j = 0; j < 4; ++j) { float v = acc[b][j]; v += __shfl_xor(v, 16); v += __shfl_xor(v, 32); if (rs == 0) red[(wave * 8 + b) * 64 + 4 * cg + j] = v; }
        __syncthreads();
        { const int b = tid >> 6, col = tid & 63; float s = b_ada[e0 + col];
#pragma unroll
          for (int w = 0; w < 8; ++w) s += red[(w * 8 + b) * 64 + col];
          mod[b * MODS + e0 + col] = s; }
        __syncthreads();
    }
}

__device__ __forceinline__ void transpose_item(const float* W, int ldw, int col0, int K, bf16* WT, int row_off, float scale, LAS float* scr, int kb, int nb, int lane) {
    const int k0 = 64 * kb, n0 = 32 * nb;
#pragma unroll 8
    for (int i = 0; i < 32; ++i) { const int kk = 2 * i + (lane >> 5); scr[kk * 33 + (lane & 31)] = W[(size_t)(k0 + kk) * ldw + col0 + n0 + (lane & 31)]; }
    LDS_WAIT(); asm volatile("" ::: "memory");
    const int c = lane & 7;
#pragma unroll
    for (int j = 0; j < 4; ++j) { const int n = (lane >> 3) + 8 * j; const LAS float* s = scr + (8 * c) * 33 + n;
        v4u o; o.x = cvtpk(s[0 * 33] * scale, s[1 * 33] * scale); o.y = cvtpk(s[2 * 33] * scale, s[3 * 33] * scale); o.z = cvtpk(s[4 * 33] * scale, s[5 * 33] * scale); o.w = cvtpk(s[6 * 33] * scale, s[7 * 33] * scale);
        *(v4u*)(WT + (size_t)(row_off + n0 + n) * K + k0 + 8 * c) = o; }
    LDS_WAIT(); asm volatile("" ::: "memory");
}
__device__ __forceinline__ bf16x8 ld8_f32_bf16(const float* p) {
    const f32x4 a = *(const f32x4*)p, b = *(const f32x4*)(p + 4);
    v4u o; o.x = cvtpk(a[0], a[1]); o.y = cvtpk(a[2], a[3]); o.z = cvtpk(b[0], b[1]); o.w = cvtpk(b[2], b[3]);
    return __builtin_bit_cast(bf16x8, o);
}
__device__ __forceinline__ void wc_item(const float* w_query, const float* sub_keys, bf16* WcT, int item, int lane) {
    const int hp = item >> 6, d0 = (item & 63) * 16, p = hp & 1;
    const int r = lane & 15, kg = lane >> 4;
    bf16x8 a[4];
#pragma unroll
    for (int ks = 0; ks < 4; ++ks) a[ks] = ld8_f32_bf16(w_query + (size_t)(d0 + r) * 2048 + hp * 128 + ks * 32 + 8 * kg);
#pragma unroll
    for (int nt = 0; nt < 8; ++nt) {
        f32x4 acc = {0.f, 0.f, 0.f, 0.f};
#pragma unroll
        for (int ks = 0; ks < 4; ++ks) { const bf16x8 b = ld8_f32_bf16(sub_keys + (size_t)(p * 128 + nt * 16 + r) * 128 + ks * 32 + 8 * kg);
            acc = __builtin_amdgcn_mfma_f32_16x16x32_bf16(a[ks], b, acc, 0, 0, 0); }
        u32x2 o; o.x = cvtpk(acc[0], acc[1]); o.y = cvtpk(acc[2], acc[3]);
        *(u32x2*)(WcT + (size_t)(hp * 128 + nt * 16 + r) * DM + d0 + 4 * kg) = o;
    }
}
struct RowStats { float mean, rstd; };
__device__ __forceinline__ RowStats row_stats(const f32x4 (&v)[4]) {
    float s = 0.f;
#pragma unroll
    for (int j = 0; j < 4; ++j) s += (v[j][0] + v[j][1]) + (v[j][2] + v[j][3]);
    const float mean = wave_sum(s) * (1.f / DM); float s2 = 0.f;
#pragma unroll
    for (int j = 0; j < 4; ++j) { const f32x4 d = v[j] - mean; s2 += (d[0] * d[0] + d[1] * d[1]) + (d[2] * d[2] + d[3] * d[3]); }
    RowStats r; r.mean = mean; r.rstd = 1.f / sqrtf(wave_sum(s2) * (1.f / DM) + LN_EPS); return r;
}
__device__ __forceinline__ void phase_prologue(const float* const* in, unsigned char* ws, LAS unsigned char* lds, int lane, int wave) {
    const float* x = in[0]; const float* w_in = in[4]; const float* w_out = in[5]; const float* w_query = in[15]; const float* sub_keys = in[16];
    const float* mod = (const float*)(ws + WS_MOD);
    LAS float* scr = (LAS float*)(lds + wave * 16384);
    const int gw = blockIdx.x * NWAVES + wave, NGW = gridDim.x * NWAVES;
    for (int it = gw; it < 2048; it += NGW) {
        const int seg = it >> 8, r = it & 255, kb = r >> 4, nb = r & 15;
        switch (seg) {
            case 0: transpose_item(w_in, 3072, 0, DM, (bf16*)(ws + WS_WQK), 0, QSCALE, scr, kb, nb, lane); break;
            case 1: transpose_item(w_in, 3072, 512, DM, (bf16*)(ws + WS_WQK), 512, 1.f, scr, kb, nb, lane); break;
            case 2: transpose_item(w_in, 3072, 1536, DM, (bf16*)(ws + WS_WQK), 1024, QSCALE, scr, kb, nb, lane); break;
            case 3: transpose_item(w_in, 3072, 2048, DM, (bf16*)(ws + WS_WQK), 1536, 1.f, scr, kb, nb, lane); break;
            case 4: transpose_item(w_in, 3072, 1024, DM, (bf16*)(ws + WS_WV), 0, 1.f, scr, kb, nb, lane); break;
            case 5: transpose_item(w_in, 3072, 2560, DM, (bf16*)(ws + WS_WV), 512, 1.f, scr, kb, nb, lane); break;
            case 6: transpose_item(w_out, 1024, 0, DM, (bf16*)(ws + WS_WO), 0, 1.f, scr, kb, nb, lane); break;
            default: transpose_item(w_out, 1024, 512, DM, (bf16*)(ws + WS_WO), 512, 1.f, scr, kb, nb, lane); break;
        }
    }
    for (int it = gw; it < 1024; it += NGW) wc_item(w_query, sub_keys, (bf16*)(ws + WS_WC), it, lane);
    for (int m = gw; m < MTOK; m += NGW) {
        const int b = m >> 11; const float* sh = mod + b * MODS; const float* scp = sh + DM;
        const f32x4* xr = (const f32x4*)(x + (size_t)m * DM) + lane;
        f32x4 v[4];
#pragma unroll
        for (int j = 0; j < 4; ++j) v[j] = xr[64 * j];
        const RowStats st = row_stats(v);
        u32x2* o8 = (u32x2*)((bf16*)(ws + WS_XN) + (size_t)m * DM) + lane;
#pragma unroll
        for (int j = 0; j < 4; ++j) { const f32x4 s4 = *((const f32x4*)scp + lane + 64 * j), h4 = *((const f32x4*)sh + lane + 64 * j);
            const f32x4 y = (v[j] - st.mean) * st.rstd * (s4 + 1.0f) + h4; u32x2 o; o.x = cvtpk(y[0], y[1]); o.y = cvtpk(y[2], y[3]); o8[64 * j] = o; }
    }
    for (int rr = gw; rr < 32768; rr += NGW) {
        const float* src = (rr < 16384) ? in[17] + (size_t)rr * DM : in[18] + (size_t)(rr - 16384) * DM;
        bf16* dst = (bf16*)(ws + WS_ED) + (size_t)rr * DM;
#pragma unroll
        for (int j = 0; j < 2; ++j) { const bf16x8 o = ld8_f32_bf16(src + 512 * j + 8 * lane); *(bf16x8*)(dst + 512 * j + 8 * lane) = o; }
    }
}

constexpr int ATT_KSTR = 144, ATT_VSTR = 136;
constexpr int ATT_K0 = 0, ATT_K1 = 64 * ATT_KSTR, ATT_V = 2 * 64 * ATT_KSTR, ATT_BUF = ATT_V + 128 * ATT_VSTR;
constexpr int ATT_TAB = 98304;
constexpr int ATT_RPB_N = 8 * 15 * 31, ATT_T5_N = 4 * 257;
static_assert(2 * ATT_BUF <= 65536 + 8192 && ATT_TAB + (ATT_RPB_N + ATT_T5_N + 4) * 4 <= RING_BYTES, "attention LDS map");

__device__ __forceinline__ int t5_bucket(int rel) {
    const int n = rel < 0 ? -rel : rel; int bucket = rel > 0 ? 16 : 0;
    const float nf = (float)(n < 1 ? 1 : n);
    int large = 8 + (int)(logf(nf / 8.0f) / 2.772588722239781f * 8.0f);
    large = large < 15 ? large : 15;
    return bucket + (n < 8 ? n : large);
}
__device__ __forceinline__ void att_tables(const float* na_rpb, const float* t5_bias, const float* lq1, const float* lk1, const float* lq2, const float* lk2, unsigned char* lds, int tid, int lane, int wave) {
    float* rpbL = (float*)(lds + ATT_TAB); float* t5L = rpbL + ATT_RPB_N; float* lamL = t5L + ATT_T5_N;
    for (int i = tid; i < ATT_RPB_N; i += 512) rpbL[i] = na_rpb[i] * LOG2E;
    for (int i = tid; i < ATT_T5_N; i += 512) { const int h = i / 257, rel = i % 257 - 128; t5L[i] = t5_bias[t5_bucket(rel) * 4 + h] * LOG2E; }
    if (wave == 0) { const float a = wave_sum(lq1[lane] * lk1[lane]), b = wave_sum(lq2[lane] * lk2[lane]); if (lane == 0) lamL[0] = expf(a) - expf(b) + LAMBDA_INIT; }
    __syncthreads();
}

__device__ __forceinline__ void na_item(int item, const bf16* QK, const bf16* VT, bf16* CC, const float* rpbL, int lane) {
    const int g = item & 3, r = (item >> 2) & 31, h = (item >> 7) & 7, b = item >> 10;
    const int qi = lane & 15, kg = lane >> 4;
    const int rs = min(max(r - 4, 0), 24);
    const int c0 = (g == 0) ? 0 : (g == 1) ? 8 : (g == 2) ? 24 : 32;
    const int qcol = 16 * g + qi, cs = min(max(qcol - 8, 0), 48);
    const size_t tokb = (size_t)b * SEQ;
    const bf16* qp = QK + (tokb + r * 64 + qcol) * 2048 + h * 64 + 8 * kg;
    const bf16x8 qf0 = *(const bf16x8*)qp, qf1 = *(const bf16x8*)(qp + 32);
    f32x4 s[16];
#pragma unroll
    for (int t = 0; t < 16; ++t) {
        const int i = t >> 1, half = t & 1;
        const bf16* kp = QK + (tokb + (rs + i) * 64 + c0 + 16 * half + qi) * 2048 + 512 + h * 64 + 8 * kg;
        const bf16x8 k0 = *(const bf16x8*)kp, k1 = *(const bf16x8*)(kp + 32);
        f32x4 a = {0.f, 0.f, 0.f, 0.f};
        a = __builtin_amdgcn_mfma_f32_16x16x32_bf16(k0, qf0, a, 0, 0, 0);
        a = __builtin_amdgcn_mfma_f32_16x16x32_bf16(k1, qf1, a, 0, 0, 0);
        s[t] = a;
    }
    float mx = -INFINITY;
#pragma unroll
    for (int t = 0; t < 16; ++t) {
        const int i = t >> 1, half = t & 1; const float* bp = rpbL + (h * 15 + (rs + i - r + 7)) * 31 + 15;
#pragma unroll
        for (int e = 0; e < 4; ++e) { const int kcol = c0 + 16 * half + 4 * kg + e; const bool valid = (kcol >= cs) && (kcol < cs + 16);
            const int co = min(max(kcol - qcol, -15), 15);
            const float v = valid ? s[t][e] + bp[co] : -INFINITY; s[t][e] = v; mx = fmaxf(mx, v); }
    }
    mx = fmaxf(mx, __shfl_xor(mx, 16)); mx = fmaxf(mx, __shfl_xor(mx, 32));
    float l = 0.f;
#pragma unroll
    for (int t = 0; t < 16; ++t)
#pragma unroll
        for (int e = 0; e < 4; ++e) { const float p = __builtin_amdgcn_exp2f(s[t][e] - mx); s[t][e] = p; l += p; }
    l += __shfl_xor(l, 16); l += __shfl_xor(l, 32);
    f32x4 o[4];
#pragma unroll
    for (int nt = 0; nt < 4; ++nt) o[nt] = (f32x4){0.f, 0.f, 0.f, 0.f};
#pragma unroll
    for (int kk = 0; kk < 8; ++kk) {
        v4u pw; pw.x = cvtpk(s[2 * kk][0], s[2 * kk][1]); pw.y = cvtpk(s[2 * kk][2], s[2 * kk][3]); pw.z = cvtpk(s[2 * kk + 1][0], s[2 * kk + 1][1]); pw.w = cvtpk(s[2 * kk + 1][2], s[2 * kk + 1][3]);
        const bf16x8 pb = __builtin_bit_cast(bf16x8, pw);
#pragma unroll
        for (int nt = 0; nt < 4; ++nt) {
            const bf16* vp = VT + (size_t)(h * 64 + nt * 16 + qi) * MTOK + tokb + (rs + kk) * 64 + c0 + 4 * kg;
            const u32x2 lo = *(const u32x2*)vp, hi = *(const u32x2*)(vp + 16);
            v4u aw; aw.x = lo.x; aw.y = lo.y; aw.z = hi.x; aw.w = hi.y;
            o[nt] = __builtin_amdgcn_mfma_f32_16x16x32_bf16(__builtin_bit_cast(bf16x8, aw), pb, o[nt], 0, 0, 0);
        }
    }
    const float inv = 1.f / l;
    bf16* op = CC + (tokb + r * 64 + qcol) * DM + h * 64 + 4 * kg;
#pragma unroll
    for (int nt = 0; nt < 4; ++nt) { u32x2 w; w.x = cvtpk(o[nt][0] * inv, o[nt][1] * inv); w.y = cvtpk(o[nt][2] * inv, o[nt][3] * inv); *(u32x2*)(op + nt * 16) = w; }
}

__device__ __forceinline__ int crow(int r, int hi) { return (r & 3) + 8 * (r >> 2) + 4 * hi; }

__device__ __forceinline__ void diff_unit(int unit, const bf16* QK, const bf16* VT, bf16* CC, const float* subln, unsigned char* lds, int tid, int lane, int wave) {
    const int qb = unit & 15, h = (unit >> 4) & 3, b = unit >> 6;
    const int mp = wave >> 2, qs = wave & 3, r32 = lane & 31, hi = lane >> 5;
    const size_t tokb = (size_t)b * SEQ;
    const int q0 = qb * 128 + qs * 32;
    const float* t5L = (const float*)(lds + ATT_TAB) + ATT_RPB_N + h * 257 + 128;
    const float lam = ((const float*)(lds + ATT_TAB))[ATT_RPB_N + ATT_T5_N];
    const float cL = t5L[-128], cR = t5L[128];
    bf16x8 qf[4];
    { const bf16* qp = QK + (tokb + q0 + r32) * 2048 + 1024 + h * 128 + mp * 64 + 8 * hi;
#pragma unroll
      for (int d0 = 0; d0 < 4; ++d0) qf[d0] = *(const bf16x8*)(qp + d0 * 16); }
    const bf16* ksrc = QK + (tokb + (tid >> 3)) * 2048 + 1536 + h * 128 + (tid & 7) * 8;
    const bf16* vsrc = VT + (size_t)(512 + h * 128 + (tid >> 3)) * MTOK + tokb + (tid & 7) * 8;
    const int kdst = (tid >> 3) * ATT_KSTR + (tid & 7) * 16, vdst = ATT_V + (tid >> 3) * ATT_VSTR + (tid & 7) * 16;
    v4u sk[2], sv[2];
#define DIFF_LOAD(t) do { sk[0] = *(const v4u*)(ksrc + (size_t)(t) * 64 * 2048); sk[1] = *(const v4u*)(ksrc + (size_t)(t) * 64 * 2048 + 64); \
        sv[0] = *(const v4u*)(vsrc + (t) * 64); sv[1] = *(const v4u*)(vsrc + (size_t)64 * MTOK + (t) * 64); } while (0)
#define DIFF_STORE(buf) do { unsigned char* bb_ = lds + (buf) * ATT_BUF; *(v4u*)(bb_ + ATT_K0 + kdst) = sk[0]; *(v4u*)(bb_ + ATT_K1 + kdst) = sk[1]; \
        *(u32x2*)(bb_ + vdst) = (u32x2){sv[0].x, sv[0].y}; *(u32x2*)(bb_ + vdst + 8) = (u32x2){sv[0].z, sv[0].w}; \
        *(u32x2*)(bb_ + vdst + 64 * ATT_VSTR) = (u32x2){sv[1].x, sv[1].y}; *(u32x2*)(bb_ + vdst + 64 * ATT_VSTR + 8) = (u32x2){sv[1].z, sv[1].w}; } while (0)
    DIFF_LOAD(0); DIFF_STORE(0); __syncthreads();
    f32x16 o[4];
#pragma unroll
    for (int k = 0; k < 4; ++k)
#pragma unroll
        for (int e = 0; e < 16; ++e) o[k][e] = 0.f;
    float m_run = -1e30f, l_run = 0.f;
    const int qpos = q0 + r32;
    for (int t = 0; t < SEQ / 64; ++t) {
        if (t + 1 < SEQ / 64) DIFF_LOAD(t + 1);
        const unsigned char* bb = lds + (t & 1) * ATT_BUF;
        const unsigned char* kb_ = bb + (mp ? ATT_K1 : ATT_K0) + r32 * ATT_KSTR + hi * 16;
        const bool farL = (64 * t + 63 - q0) <= -91, farR = (64 * t - (q0 + 31)) >= 91;
        const float cinit = farL ? cL : (farR ? cR : 0.f);
        f32x16 p0, p1;
#pragma unroll
        for (int e = 0; e < 16; ++e) { p0[e] = cinit; p1[e] = cinit; }
#pragma unroll
        for (int d0 = 0; d0 < 4; ++d0) {
            const bf16x8 ka = *(const bf16x8*)(kb_ + d0 * 32), kc = *(const bf16x8*)(kb_ + 32 * ATT_KSTR + d0 * 32);
            p0 = __builtin_amdgcn_mfma_f32_32x32x16_bf16(ka, qf[d0], p0, 0, 0, 0);
            p1 = __builtin_amdgcn_mfma_f32_32x32x16_bf16(kc, qf[d0], p1, 0, 0, 0);
        }
        if (!(farL || farR)) {
            const int rel0 = 64 * t - qpos;
#pragma unroll
            for (int e = 0; e < 16; ++e) { const int ra = rel0 + crow(e, hi); const int rb = ra + 32;
                p0[e] += t5L[min(max(ra, -128), 128)]; p1[e] += t5L[min(max(rb, -128), 128)]; }
        }
        float mx = p0[0];
#pragma unroll
        for (int e = 1; e < 16; ++e) mx = fmaxf(mx, p0[e]);
#pragma unroll
        for (int e = 0; e < 16; ++e) mx = fmaxf(mx, p1[e]);
        mx = fmaxf(mx, __shfl_xor(mx, 32));
        const float m_new = fmaxf(m_run, mx), alpha = __builtin_amdgcn_exp2f(m_run - m_new);
        m_run = m_new;
        float ls = 0.f;
#pragma unroll
        for (int e = 0; e < 16; ++e) { p0[e] = __builtin_amdgcn_exp2f(p0[e] - m_new); p1[e] = __builtin_amdgcn_exp2f(p1[e] - m_new); ls += p0[e] + p1[e]; }
        l_run = l_run * alpha + ls;
#pragma unroll
        for (int k = 0; k < 4; ++k)
#pragma unroll
            for (int e = 0; e < 16; ++e) o[k][e] *= alpha;
        bf16x8 pf[4];
        { v4u w;
          w.x = cvtpk(p0[0], p0[1]); w.y = cvtpk(p0[2], p0[3]); w.z = cvtpk(p0[4], p0[5]); w.w = cvtpk(p0[6], p0[7]); pf[0] = __builtin_bit_cast(bf16x8, w);
          w.x = cvtpk(p0[8], p0[9]); w.y = cvtpk(p0[10], p0[11]); w.z = cvtpk(p0[12], p0[13]); w.w = cvtpk(p0[14], p0[15]); pf[1] = __builtin_bit_cast(bf16x8, w);
          w.x = cvtpk(p1[0], p1[1]); w.y = cvtpk(p1[2], p1[3]); w.z = cvtpk(p1[4], p1[5]); w.w = cvtpk(p1[6], p1[7]); pf[2] = __builtin_bit_cast(bf16x8, w);
          w.x = cvtpk(p1[8], p1[9]); w.y = cvtpk(p1[10], p1[11]); w.z = cvtpk(p1[12], p1[13]); w.w = cvtpk(p1[14], p1[15]); pf[3] = __builtin_bit_cast(bf16x8, w); }
        const unsigned char* vb_ = bb + ATT_V + r32 * ATT_VSTR + hi * 8;
#pragma unroll
        for (int blk = 0; blk < 4; ++blk)
#pragma unroll
            for (int ks = 0; ks < 4; ++ks) {
                const unsigned char* vp = vb_ + blk * 32 * ATT_VSTR + ks * 32;
                const u32x2 lo = *(const u32x2*)vp, hv = *(const u32x2*)(vp + 16);
                v4u aw; aw.x = lo.x; aw.y = lo.y; aw.z = hv.x; aw.w = hv.y;
                o[blk] = __builtin_amdgcn_mfma_f32_32x32x16_bf16(__builtin_bit_cast(bf16x8, aw), pf[ks], o[blk], 0, 0, 0);
            }
        if (t + 1 < SEQ / 64) DIFF_STORE((t + 1) & 1);
        __syncthreads();
    }
#undef DIFF_LOAD
#undef DIFF_STORE
    const float ltot = l_run + __shfl_xor(l_run, 32);
    const float inv = (mp ? lam : 1.f) / ltot;
    float* exch = (float*)lds + qs * 4096;
    if (mp == 1) {
#pragma unroll
        for (int k = 0; k < 4; ++k)
#pragma unroll
            for (int e = 0; e < 16; ++e) exch[(k * 16 + e) * 64 + lane] = o[k][e] * inv;
    }
    __syncthreads();
    if (mp == 0) {
        float ss = 0.f;
#pragma unroll
        for (int k = 0; k < 4; ++k)
#pragma unroll
            for (int e = 0; e < 16; ++e) { const float d = o[k][e] * inv - exch[(k * 16 + e) * 64 + lane]; o[k][e] = d; ss += d * d; }
        ss += __shfl_xor(ss, 32);
        const float rn = (1.0f - LAMBDA_INIT) / sqrtf(ss * (1.f / 128.f) + LN_EPS);
        bf16* op = CC + (tokb + q0 + r32) * DM + 512 + h * 128 + 4 * hi;
#pragma unroll
        for (int k = 0; k < 4; ++k)
#pragma unroll
            for (int g4 = 0; g4 < 4; ++g4) { const int dv = k * 32 + 8 * g4 + 4 * hi; const f32x4 sg = *(const f32x4*)(subln + dv);
                u32x2 w; w.x = cvtpk(o[k][4 * g4] * rn * sg[0], o[k][4 * g4 + 1] * rn * sg[1]); w.y = cvtpk(o[k][4 * g4 + 2] * rn * sg[2], o[k][4 * g4 + 3] * rn * sg[3]);
                *(u32x2*)(op + k * 32 + 8 * g4) = w; }
    }
    __syncthreads();
}

__device__ __forceinline__ void phase_attention(const float* const* in, unsigned char* ws, unsigned char* lds, int tid, int lane, int wave) {
    const bf16* QK = (const bf16*)(ws + WS_QK); const bf16* VT = (const bf16*)(ws + WS_VT); bf16* CC = (bf16*)(ws + WS_CC);
    att_tables(in[6], in[7], in[8], in[9], in[10], in[11], lds, tid, lane, wave);
    for (int u = blockIdx.x; u < 512; u += gridDim.x) diff_unit(u, QK, VT, CC, in[12], lds, tid, lane, wave);
    const float* rpbL = (const float*)(lds + ATT_TAB);
    const int gw = blockIdx.x * NWAVES + wave, NGW = gridDim.x * NWAVES;
    for (int it = gw; it < 8192; it += NGW) na_item(it, QK, VT, CC, rpbL, lane);
}

__device__ __forceinline__ void phase_rows(const float* const* in, unsigned char* ws, float* X1, int lane, int wave) {
    const float* Y = (const float*)(ws + WS_Y); const float* mod = (const float*)(ws + WS_MOD); bf16* H2 = (bf16*)(ws + WS_H2);
    const float* g1 = in[13]; const float* b1 = in[14];
    const int gw = blockIdx.x * NWAVES + wave, NGW = gridDim.x * NWAVES;
    for (int m = gw; m < MTOK; m += NGW) {
        const int b = m >> 11; const float* sh = mod + b * MODS + 3 * DM; const float* scp = mod + b * MODS + 4 * DM;
        const f32x4* yr = (const f32x4*)(Y + (size_t)m * DM) + lane;
        f32x4 v[4];
#pragma unroll
        for (int j = 0; j < 4; ++j) v[j] = yr[64 * j];
        const RowStats s1 = row_stats(v);
        f32x4* xo = (f32x4*)(X1 + (size_t)m * DM) + lane;
#pragma unroll
        for (int j = 0; j < 4; ++j) { const f32x4 gg = *((const f32x4*)g1 + lane + 64 * j), bb = *((const f32x4*)b1 + lane + 64 * j);
            v[j] = (v[j] - s1.mean) * s1.rstd * gg + bb; xo[64 * j] = v[j]; }
        const RowStats s2 = row_stats(v);
        u32x2* o8 = (u32x2*)(H2 + (size_t)m * DM) + lane;
#pragma unroll
        for (int j = 0; j < 4; ++j) { const f32x4 s4 = *((const f32x4*)scp + lane + 64 * j), h4 = *((const f32x4*)sh + lane + 64 * j);
            const f32x4 y = (v[j] - s2.mean) * s2.rstd * (s4 + 1.0f) + h4; u32x2 o; o.x = cvtpk(y[0], y[1]); o.y = cvtpk(y[2], y[3]); o8[64 * j] = o; }
    }
}

__device__ __forceinline__ unsigned key_enc(float v, int n) { const unsigned u = __builtin_bit_cast(unsigned, v); const unsigned k = u ^ (((int)u >> 31) | 0x80000000u); return (k & ~127u) | (unsigned)(127 - n); }
__device__ __forceinline__ float key_val(unsigned k) { k &= ~127u; const unsigned u = (k & 0x80000000u) ? (k ^ 0x80000000u) : ~k; return __builtin_bit_cast(float, u); }
__device__ __forceinline__ int key_idx(unsigned k) { return 127 - (int)(k & 127u); }
__device__ __forceinline__ float gelu_erf(float x) { return 0.5f * x * (1.f + erff(x * 0.70710678118654752f)); }

constexpr int PE_TOK = 64;
constexpr int PE_ID = 0, PE_G = 32768;
__device__ __forceinline__ void phase_peer(const float* const* in, unsigned char* ws, float* OUT  , unsigned char* lds, int tid, int lane, int wave) {
    const float* ST = (const float*)(ws + WS_ST); const bf16* H2 = (const bf16*)(ws + WS_H2);
    const bf16* ED = (const bf16*)(ws + WS_ED); const bf16* EU = (const bf16*)(ws + WS_EU);
    const float* mod = (const float*)(ws + WS_MOD); const float* g2 = in[19]; const float* b2 = in[20];
    int* idL = (int*)(lds + PE_ID); float* gL = (float*)(lds + PE_G);
    for (int tile = blockIdx.x; tile < MTOK / PE_TOK; tile += gridDim.x) {
        const int tok0 = tile * PE_TOK;
        {
            unsigned tk[2][16];
#pragma unroll
            for (int p = 0; p < 2; ++p) {
#pragma unroll
                for (int i = 0; i < 16; ++i) tk[p][i] = 0u;
                const float* sp = ST + (size_t)(wave * 256 + p * 128) * MTOK + tok0 + lane;
#pragma unroll 8
                for (int n = 0; n < 128; ++n) {
                    unsigned v = key_enc(sp[(size_t)n * MTOK], n);
#pragma unroll
                    for (int i = 0; i < 16; ++i) { const unsigned hi_ = max(tk[p][i], v); v = min(tk[p][i], v); tk[p][i] = hi_; }
                }
            }
            float bv[16]; int bi[16];
#pragma unroll
            for (int i = 0; i < 16; ++i) { bv[i] = -INFINITY; bi[i] = 0; }
#pragma unroll
            for (int i = 0; i < 16; ++i)
#pragma unroll
                for (int j = 0; j < 16; ++j) if ((i + 1) * (j + 1) <= 16) {
                    float v = key_val(tk[0][i]) + key_val(tk[1][j]); int id = key_idx(tk[0][i]) * 128 + key_idx(tk[1][j]);
#pragma unroll
                    for (int k = 0; k < 16; ++k) { const bool c = v > bv[k]; const float nv = c ? bv[k] : v; const int ni = c ? bi[k] : id; bv[k] = c ? v : bv[k]; bi[k] = c ? id : bi[k]; v = nv; id = ni; }
                }
            float sum = 0.f; const float bmax = bv[0];
#pragma unroll
            for (int k = 0; k < 16; ++k) { bv[k] = __expf(bv[k] - bmax); sum += bv[k]; }
            const float rinv = 1.f / sum;
#pragma unroll
            for (int k = 0; k < 16; ++k) { idL[(wave * 16 + k) * 64 + lane] = bi[k]; gL[(wave * 16 + k) * 64 + lane] = bv[k] * rinv; }
        }
        __syncthreads();
        for (int tt = 0; tt < PE_TOK / NWAVES; ++tt) {
            const int tl = wave * (PE_TOK / NWAVES) + tt, m = tok0 + tl, b = m >> 11;
            const int id0 = idL[lane * 64 + tl], id1 = idL[(lane + 64) * 64 + tl];
            const float gg0 = gL[lane * 64 + tl], gg1 = gL[(lane + 64) * 64 + tl];
            v4u hx[2];
            { const v4u* hp = (const v4u*)(H2 + (size_t)m * DM + 16 * lane); hx[0] = hp[0]; hx[1] = hp[1]; }
            float acc[16];
#pragma unroll
            for (int i = 0; i < 16; ++i) acc[i] = 0.f;
            for (int e0 = 0; e0 < 128; e0 += 8) {
                v4u uw[8][2], vw[8][2]; float gv[8];
#pragma unroll
                for (int j = 0; j < 8; ++j) {
                    const int e = e0 + j;
                    const int row = (e0 < 64) ? __builtin_amdgcn_readlane(id0, e & 63) : __builtin_amdgcn_readlane(id1, e & 63);
                    gv[j] = (e0 < 64) ? __builtin_bit_cast(float, __builtin_amdgcn_readlane(__builtin_bit_cast(int, gg0), e & 63)) : __builtin_bit_cast(float, __builtin_amdgcn_readlane(__builtin_bit_cast(int, gg1), e & 63));
                    const v4u* up = (const v4u*)(ED + (size_t)row * DM + 16 * lane); uw[j][0] = up[0]; uw[j][1] = up[1];
                    const v4u* vp = (const v4u*)(EU + (size_t)row * DM + 16 * lane); vw[j][0] = vp[0]; vw[j][1] = vp[1];
                }
                float d[8];
#pragma unroll
                for (int j = 0; j < 8; ++j) { float a = 0.f;
                    a = dot2bf(uw[j][0].x, hx[0].x, a); a = dot2bf(uw[j][0].y, hx[0].y, a); a = dot2bf(uw[j][0].z, hx[0].z, a); a = dot2bf(uw[j][0].w, hx[0].w, a);
                    a = dot2bf(uw[j][1].x, hx[1].x, a); a = dot2bf(uw[j][1].y, hx[1].y, a); a = dot2bf(uw[j][1].z, hx[1].z, a); a = dot2bf(uw[j][1].w, hx[1].w, a);
                    d[j] = a; }
#pragma unroll
                for (int o = 1; o < 64; o <<= 1)
#pragma unroll
                    for (int j = 0; j < 8; ++j) d[j] += __shfl_xor(d[j], o);
#pragma unroll
                for (int j = 0; j < 8; ++j) {
                    const float cf = gv[j] * gelu_erf(d[j]);
                    acc[0] += cf * bf_lo(vw[j][0].x); acc[1] += cf * bf_hi(vw[j][0].x); acc[2] += cf * bf_lo(vw[j][0].y); acc[3] += cf * bf_hi(vw[j][0].y);
                    acc[4] += cf * bf_lo(vw[j][0].z); acc[5] += cf * bf_hi(vw[j][0].z); acc[6] += cf * bf_lo(vw[j][0].w); acc[7] += cf * bf_hi(vw[j][0].w);
                    acc[8] += cf * bf_lo(vw[j][1].x); acc[9] += cf * bf_hi(vw[j][1].x); acc[10] += cf * bf_lo(vw[j][1].y); acc[11] += cf * bf_hi(vw[j][1].y);
                    acc[12] += cf * bf_lo(vw[j][1].z); acc[13] += cf * bf_hi(vw[j][1].z); acc[14] += cf * bf_lo(vw[j][1].w); acc[15] += cf * bf_hi(vw[j][1].w);
                }
            }
            const float* gf = mod + b * MODS + 5 * DM + 16 * lane;
            float* xr = OUT + (size_t)m * DM + 16 * lane;
            f32x4 y[4]; float s = 0.f;
#pragma unroll
            for (int j = 0; j < 4; ++j) { const f32x4 xv = *(const f32x4*)(xr + 4 * j), gv4 = *(const f32x4*)(gf + 4 * j);
                const f32x4 fv = {acc[4 * j], acc[4 * j + 1], acc[4 * j + 2], acc[4 * j + 3]};
                y[j] = xv * DN_ALPHA + (gv4 + 1.0f) * fv; s += (y[j][0] + y[j][1]) + (y[j][2] + y[j][3]); }
            const float mean = wave_sum(s) * (1.f / DM); float s2 = 0.f;
#pragma unroll
            for (int j = 0; j < 4; ++j) { const f32x4 dd = y[j] - mean; s2 += (dd[0] * dd[0] + dd[1] * dd[1]) + (dd[2] * dd[2] + dd[3] * dd[3]); }
            const float rstd = 1.f / sqrtf(wave_sum(s2) * (1.f / DM) + LN_EPS);
#pragma unroll
            for (int j = 0; j < 4; ++j) { const f32x4 gg = *(const f32x4*)(g2 + 16 * lane + 4 * j), bb = *(const f32x4*)(b2 + 16 * lane + 4 * j);
                *(f32x4*)(xr + 4 * j) = (y[j] - mean) * rstd * gg + bb; }
        }
        __syncthreads();
    }
}

struct Args { const float* in[21]; float* out; unsigned char* ws; int ph_lo, ph_hi; };
__global__ void __launch_bounds__(NWAVES * 64, 2) fwd_kernel(Args args) {
    extern __shared__ __attribute__((aligned(16))) unsigned char lds[];
    LAS unsigned char* ldsl = (LAS unsigned char*)lds;
    const int tid = threadIdx.x, lane = tid & 63, wave = __builtin_amdgcn_readfirstlane(tid >> 6);
    const int G = gridDim.x;
    unsigned char* ws = args.ws;
    gu32* ctl = (gu32*)(ws + WS_CTL);
    for (int u = tid; u < (LDS_BYTES - LDSCTL_OFF) / 4; u += NWAVES * 64) ((LAS unsigned*)(ldsl + LDSCTL_OFF))[u] = 0u;
    __syncthreads();
    XcdBarrier bar; bar.bar = (unsigned*)(ctl + CW_BAR); bar.x = 0; bar.st = nullptr;
    if (N_LAUNCHES == 1) bar = xcd_barrier_post((unsigned*)(ctl + CW_BAR), (volatile LAS unsigned*)(ldsl + MISC_OFF) + 8);
    const int lo = args.ph_lo, hi = args.ph_hi;
#define IN(k) (lo <= (k) && (k) < hi)
#define SEAM(k) do { if (IN(k) && IN((k) + 1)) xcd_barrier(bar); } while (0)

    if (IN(0)) { phase_mod(args.in[1], args.in[2], args.in[3], (float*)(ws + WS_MOD), lds, tid, lane, wave); }
    SEAM(0);
    if (IN(1)) { phase_prologue(args.in, ws, ldsl, lane, wave); }
    SEAM(1);
    if (IN(2)) {
        { pg8::Gemm g{(const bf16*)(ws + WS_XN), (const bf16*)(ws + WS_WQK), MTOK, 2048, DM}; pg8::StaticOrder S; S.init(MTOK, 2048, G, (int)blockIdx.x);
          pg8::EpiBf16 E{(bf16*)(ws + WS_QK), 2048};
          pg8::gemm_phase<pg8::EpiBf16, pg8::StaticOrder, true, true>(ldsl, g, S, E); }
        __syncthreads();
        { pg8::Gemm g{(const bf16*)(ws + WS_WV), (const bf16*)(ws + WS_XN), 1024, MTOK, DM}; pg8::StaticOrder S; S.init(1024, MTOK, G, (int)blockIdx.x);
          pg8::EpiBf16 E{(bf16*)(ws + WS_VT), MTOK};
          pg8::gemm_phase<pg8::EpiBf16, pg8::StaticOrder, true, true>(ldsl, g, S, E); }
    }
    SEAM(2);
    if (IN(3)) { __syncthreads(); phase_attention(args.in, ws, lds, tid, lane, wave); }
    SEAM(3);
    if (IN(4)) {
        pg8::Gemm g{(const bf16*)(ws + WS_CC), (const bf16*)(ws + WS_WO), MTOK, DM, DM}; pg8::StaticOrder S; S.init(MTOK, DM, G, (int)blockIdx.x);
        pg8::EpiY E{args.in[0], (const float*)(ws + WS_MOD) + 2 * DM, MODS, (float*)(ws + WS_Y), DN_ALPHA};
        pg8::gemm_phase<pg8::EpiY, pg8::StaticOrder, true, true>(ldsl, g, S, E);
    }
    SEAM(4);
    if (IN(5)) { phase_rows(args.in, ws, args.out, lane, wave); }
    SEAM(5);
    if (IN(6)) {
        pg8::Gemm g{(const bf16*)(ws + WS_WC), (const bf16*)(ws + WS_H2), 2048, MTOK, DM}; pg8::StaticOrder S; S.init(2048, MTOK, G, (int)blockIdx.x);
        pg8::EpiF32 E{(float*)(ws + WS_ST), MTOK};
        pg8::gemm_phase<pg8::EpiF32, pg8::StaticOrder, true, true>(ldsl, g, S, E);
    }
    SEAM(6);
    if (IN(7)) { __syncthreads(); phase_peer(args.in, ws, args.out, lds, tid, lane, wave); }
#undef IN
#undef SEAM
}

extern "C" void kernel_launch(void* const* d_in, const int* in_sizes, int n_in, void* d_out, int out_size, void* d_ws, size_t ws_size, hipStream_t stream) {
    static int grid = 0;
    if (grid == 0) {
        if (n_in != 21 || out_size != MTOK * DM || ws_size < WS_END) { fprintf(stderr, "kernel_launch: unexpected shapes (n_in %d out %d ws %zu)\n", n_in, out_size, ws_size); grid = -1; return; }
        int dev = 0, cus = 0, per_cu = 0;
        if (hipGetDevice(&dev) != hipSuccess || hipDeviceGetAttribute(&cus, hipDeviceAttributeMultiprocessorCount, dev) != hipSuccess) { grid = -1; return; }
        if (hipFuncSetAttribute((const void*)fwd_kernel, hipFuncAttributeMaxDynamicSharedMemorySize, LDS_BYTES) != hipSuccess) { fprintf(stderr, "kernel_launch: hipFuncSetAttribute failed\n"); grid = -1; return; }
        if (hipOccupancyMaxActiveBlocksPerMultiprocessor(&per_cu, (const void*)fwd_kernel, NWAVES * 64, LDS_BYTES) != hipSuccess || per_cu < 1) { fprintf(stderr, "kernel_launch: occupancy query says %d\n", per_cu); }
        (void)hipGetLastError();
        grid = cus;
    }
    if (grid < 0) return;
    if (hipMemsetAsync((char*)d_ws + WS_CTL, 0, CTL_ZERO_BYTES, stream) != hipSuccess) return;
    Args a{};
    for (int i = 0; i < 21; ++i) a.in[i] = (const float*)d_in[i];
    a.out = (float*)d_out; a.ws = (unsigned char*)d_ws;
    if (N_LAUNCHES == 1) { a.ph_lo = 0; a.ph_hi = N_PHASES; hipLaunchKernelGGL(fwd_kernel, dim3(grid), dim3(NWAVES * 64), LDS_BYTES, stream, a); }
    else { for (int p = 0; p < N_PHASES; ++p) { a.ph_lo = p; a.ph_hi = p + 1; hipLaunchKernelGGL(fwd_kernel, dim3(grid), dim3(NWAVES * 64), LDS_BYTES, stream, a); } }
}
```

```cpp
#include <hip/hip_runtime.h>
#include <hip/hip_bf16.h>
#include <cstdio>
#include <cstdint>
#include <cmath>
namespace pg8 {
#define PG8_LAS __attribute__((address_space(3)))
typedef unsigned short bf16_t;
typedef short bf16x8 __attribute__((ext_vector_type(8)));
typedef float f32x4 __attribute__((ext_vector_type(4)));
typedef unsigned u32x4 __attribute__((ext_vector_type(4)));
constexpr int BM = 256, BK = 64, HALF = 128, HTB = HALF * BK * 2  , STAGE_BYTES = 8 * HTB, NXCD = 8, WGM = 8;

__host__ __device__ __forceinline__ int lds_byte(int r, int c) { const int st = (r >> 4) * 2 + (c >> 5), rr = r & 15, cc = c & 31, ob = rr * 64 + cc * 2; return st * 1024 + (ob ^ (((ob >> 9) & 1) << 5)); }
__host__ __device__ __forceinline__ void stage_rc(int b, int& R, int& C) { const int st = b / 1024, sb = b % 1024, swz = sb ^ (((sb >> 9) & 1) << 5); R = (st >> 1) * 16 + swz / 64; C = (st & 1) * 32 + (swz % 64) / 2; }
__host__ __device__ __forceinline__ int perm32(int rho) { const int n = rho >> 4, i = rho & 15; return 8 * (i >> 2) + 4 * n + (i & 3); }

struct Unit { int pm, pn; };
struct Gemm { const bf16_t* A; const bf16_t* Bt; int M, N, K; };

struct StaticOrder {
    int nM, nN, nwg, G, c;
    __host__ __device__ void init(int M, int N, int G_, int c_) { nM = M / BM; nN = N / BM; nwg = nM * nN; G = G_; c = c_; }
    __host__ __device__ bool next(int i, Unit& u) const {
        const long L = (long)i * G + c; if (L >= nwg) return false;
        int wgid = (int)L; { const int q = nwg / NXCD, r = nwg % NXCD, xcd = wgid % NXCD, off = wgid / NXCD; wgid = (xcd < r ? xcd * (q + 1) : r * (q + 1) + (xcd - r) * q) + off; }
        const int nig = WGM * nN, gid = wgid / nig, fm = gid * WGM, gsz = (nM - fm) < WGM ? (nM - fm) : WGM;
        u.pm = fm + ((wgid % nig) % gsz); u.pn = (wgid % nig) / gsz; return true;
    }
    __device__ __forceinline__ void a_ready(const Unit&) const {}
    __device__ __forceinline__ void done(const Unit&) const {}
};

__device__ __forceinline__ unsigned cvt_pk_bf16(float lo, float hi) { unsigned r; asm volatile("v_cvt_pk_bf16_f32 %0, %1, %2" : "=v"(r) : "v"(lo), "v"(hi)); return r; }
typedef float f32x2 __attribute__((ext_vector_type(2)));
struct EpiBf16 {
    static constexpr bool PERM = true, AFTER_DRAIN = false;
    bf16_t* O; int ldc;
    __device__ __forceinline__ void operator()(const f32x4 (&acc)[2][2][4][2], const Unit& u, int wr, int wc, int fr, int fq) const {
        const int row0 = u.pm * BM + wr * 64 + fr; const int col0 = u.pn * BM + wc * 32 + 8 * fq;
#pragma unroll
        for (int ai = 0; ai < 2; ++ai)
#pragma unroll
            for (int m = 0; m < 4; ++m) { bf16_t* rowp = O + (size_t)(row0 + ai * HALF + m * 16) * ldc + col0;
#pragma unroll
                for (int bj = 0; bj < 2; ++bj) { const f32x4 v0 = acc[ai][bj][m][0], v1 = acc[ai][bj][m][1];
                    u32x4 w; w.x = cvt_pk_bf16(v0[0], v0[1]); w.y = cvt_pk_bf16(v0[2], v0[3]); w.z = cvt_pk_bf16(v1[0], v1[1]); w.w = cvt_pk_bf16(v1[2], v1[3]);
                    *(u32x4*)(rowp + bj * HALF) = w; } }
    }
};
struct EpiF32 {
    static constexpr bool PERM = false, AFTER_DRAIN = false;
    float* O; int ldc;
    __device__ __forceinline__ void operator()(const f32x4 (&acc)[2][2][4][2], const Unit& u, int wr, int wc, int fr, int fq) const {
        const int row0 = u.pm * BM + wr * 64 + fr; const int col0 = u.pn * BM + wc * 32 + 4 * fq;
#pragma unroll
        for (int ai = 0; ai < 2; ++ai)
#pragma unroll
            for (int m = 0; m < 4; ++m) { float* rowp = O + (size_t)(row0 + ai * HALF + m * 16) * ldc + col0;
#pragma unroll
                for (int bj = 0; bj < 2; ++bj)
#pragma unroll
                    for (int n = 0; n < 2; ++n) *(f32x4*)(rowp + bj * HALF + n * 16) = acc[ai][bj][m][n]; }
    }
};
struct EpiY {
    static constexpr bool PERM = false, AFTER_DRAIN = false;
    const float* X; const float* gate;   int gstride; float* Y; float alpha;
    __device__ __forceinline__ void operator()(const f32x4 (&acc)[2][2][4][2], const Unit& u, int wr, int wc, int fr, int fq) const {
        const int row0 = u.pm * BM + wr * 64 + fr; const int col0 = u.pn * BM + wc * 32 + 4 * fq;
        const float* gp = gate + (size_t)((u.pm * BM) >> 11) * gstride + col0;
        f32x4 gv[2][2];
#pragma unroll
        for (int bj = 0; bj < 2; ++bj)
#pragma unroll
            for (int n = 0; n < 2; ++n) gv[bj][n] = *(const f32x4*)(gp + bj * HALF + n * 16) + 1.0f;
#pragma unroll
        for (int ai = 0; ai < 2; ++ai)
#pragma unroll
            for (int m = 0; m < 4; ++m) { const size_t off = (size_t)(row0 + ai * HALF + m * 16) * 1024 + col0;
#pragma unroll
                for (int bj = 0; bj < 2; ++bj)
#pragma unroll
                    for (int n = 0; n < 2; ++n) { const f32x4 xv = *(const f32x4*)(X + off + bj * HALF + n * 16);
                        *(f32x4*)(Y + off + bj * HALF + n * 16) = xv * alpha + gv[bj][n] * acc[ai][bj][m][n]; } }
    }
};

template <class Epi, class Sched, bool ALIGN_EPI = false, bool SP2 = false>
__device__ __forceinline__ void gemm_phase(PG8_LAS unsigned char* lds, const Gemm g, const Sched& S, const Epi& E) {
    const int tid = threadIdx.x, wid = __builtin_amdgcn_readfirstlane(tid >> 6), lane = tid & 63, wr = wid >> 2, wc = wid & 3, fr = lane & 15, fq = lane >> 4;
    const int K = g.K, nt = K / BK;
    unsigned voffA[2], voffB[2];
#pragma unroll
    for (int i = 0; i < 2; ++i) { int R, C; stage_rc(tid * 16 + i * 8192, R, C); const int Rb = Epi::PERM ? ((R & ~31) + perm32(R & 31)) : R;
        voffA[i] = (unsigned)(R * K + C) * 2u; voffB[i] = (unsigned)(Rb * K + C) * 2u; }
    const size_t kstep = (size_t)(BK * 2);
    const size_t hstep = (size_t)HALF * K * 2;
    const size_t tstep = 2 * hstep;
    const unsigned ldsw = (unsigned)wid * 1024u;
    const int aoff = lds_byte(wr * 64 + fr, fq * 8), boff = lds_byte(wc * 32 + fr, fq * 8);
#define PG8_SA(b, h) (((b) * 2 + (h)) * HTB)
#define PG8_SB(b, h) ((4 + (b) * 2 + (h)) * HTB)
#define PG8_STAGE(bufoff, gbase, voff) do { _Pragma("unroll") for (int _i = 0; _i < 2; ++_i) \
        __builtin_amdgcn_global_load_lds((const unsigned*)((const char*)(gbase) + (voff)[_i]), (PG8_LAS unsigned*)(lds + (bufoff) + ldsw + _i * 8192), 16, 0, 0); } while (0)
#define PG8_LDA(dst, b, h) do { _Pragma("unroll") for (int m = 0; m < 4; ++m) _Pragma("unroll") for (int k = 0; k < 2; ++k) dst[m][k] = *(const PG8_LAS bf16x8*)(lds + PG8_SA(b, h) + aoff + m * 2048 + k * 1024); } while (0)
#define PG8_LDB(dst, b, h) do { _Pragma("unroll") for (int n = 0; n < 2; ++n) _Pragma("unroll") for (int k = 0; k < 2; ++k) dst[n][k] = *(const PG8_LAS bf16x8*)(lds + PG8_SB(b, h) + boff + n * 2048 + k * 1024); } while (0)
#define PG8_MMA(ai, bj, At, Bt) do { __builtin_amdgcn_s_setprio(1); _Pragma("unroll") for (int m = 0; m < 4; ++m) _Pragma("unroll") for (int n = 0; n < 2; ++n) _Pragma("unroll") for (int k = 0; k < 2; ++k) \
        acc[ai][bj][m][n] = __builtin_amdgcn_mfma_f32_16x16x32_bf16(Bt[n][k], At[m][k], acc[ai][bj][m][n], 0, 0, 0); __builtin_amdgcn_s_setprio(0); } while (0)
#define PG8_WAIT_V(n) asm volatile("s_waitcnt vmcnt(" #n ")" ::: "memory")
#define PG8_WAIT_L(n) asm volatile("s_waitcnt lgkmcnt(" #n ")" ::: "memory")
#define PG8_BAR __builtin_amdgcn_s_barrier()
#define PG8_SCHED __builtin_amdgcn_sched_barrier(0)
    Unit cur, nxt; int ui = 0;
    if (!S.next(0, cur)) return;
    f32x4 acc[2][2][4][2];
#pragma unroll
    for (int a = 0; a < 2; ++a)
#pragma unroll
        for (int b = 0; b < 2; ++b)
#pragma unroll
            for (int m = 0; m < 4; ++m)
#pragma unroll
                for (int n = 0; n < 2; ++n) acc[a][b][m][n] = (f32x4){0.f, 0.f, 0.f, 0.f};
    bf16x8 At[4][2], B0[2][2], B1[2][2];
    const char* cA = (const char*)g.A + (size_t)cur.pm * tstep; const char* cB = (const char*)g.Bt + (size_t)cur.pn * tstep;
    S.a_ready(cur);
    if constexpr (SP2) {
        PG8_STAGE(PG8_SB(0, 0), cB, voffB); PG8_STAGE(PG8_SB(0, 1), cB + hstep, voffB); PG8_STAGE(PG8_SA(0, 0), cA, voffA); PG8_STAGE(PG8_SA(0, 1), cA + hstep, voffA);
        if (wr == 1) PG8_BAR;
        PG8_WAIT_V(2); PG8_BAR;
        PG8_STAGE(PG8_SB(1, 0), cB + kstep, voffB); PG8_STAGE(PG8_SA(1, 0), cA + kstep, voffA); PG8_STAGE(PG8_SB(1, 1), cB + hstep + kstep, voffB);
        PG8_WAIT_V(6); PG8_BAR;
    } else {
        PG8_STAGE(PG8_SB(0, 0), cB, voffB); PG8_STAGE(PG8_SA(0, 0), cA, voffA); PG8_STAGE(PG8_SB(0, 1), cB + hstep, voffB); PG8_STAGE(PG8_SA(0, 1), cA + hstep, voffA);
        if (wr == 1) PG8_BAR;
        PG8_WAIT_V(4); PG8_BAR;
        PG8_STAGE(PG8_SB(1, 0), cB + kstep, voffB); PG8_STAGE(PG8_SA(1, 0), cA + kstep, voffA); PG8_STAGE(PG8_SB(1, 1), cB + hstep + kstep, voffB);
        PG8_WAIT_V(6); PG8_BAR;
    }
    for (;;) {
        const bool has_next = S.next(ui + 1, nxt);
        const char* nA = has_next ? (const char*)g.A + (size_t)nxt.pm * tstep : cA; const char* nB = has_next ? (const char*)g.Bt + (size_t)nxt.pn * tstep : cB;
        for (int t = 0; t < nt; t += 2) {
            const bool last = (t == nt - 2);
            const char* a1 = cA + (size_t)(t + 1) * kstep;
            const char* a2 = last ? nA : cA + (size_t)(t + 2) * kstep; const char* b2 = last ? nB : cB + (size_t)(t + 2) * kstep;
            const char* a3 = a2 + kstep; const char* b3 = b2 + kstep;
            if (last && has_next) S.a_ready(nxt);
            if constexpr (SP2) {
            PG8_LDB(B0, 0, 0); PG8_LDB(B1, 0, 1); PG8_SCHED; PG8_LDA(At, 0, 0); PG8_STAGE(PG8_SA(1, 1), a1 + hstep, voffA);
            PG8_WAIT_V(8); PG8_WAIT_L(0); PG8_BAR; PG8_MMA(0, 0, At, B0); PG8_MMA(0, 1, At, B1); PG8_BAR; PG8_SCHED;
            PG8_LDA(At, 0, 1); PG8_STAGE(PG8_SB(0, 0), b2, voffB); PG8_STAGE(PG8_SB(0, 1), b2 + hstep, voffB); PG8_STAGE(PG8_SA(0, 0), a2, voffA);
            PG8_WAIT_V(8); PG8_WAIT_L(0); PG8_BAR; PG8_MMA(1, 0, At, B0); PG8_MMA(1, 1, At, B1); PG8_BAR; PG8_SCHED;
            PG8_LDB(B0, 1, 0); PG8_LDB(B1, 1, 1); PG8_SCHED; PG8_LDA(At, 1, 0); PG8_STAGE(PG8_SA(0, 1), a2 + hstep, voffA);
            PG8_WAIT_V(8); PG8_WAIT_L(0); PG8_BAR; PG8_MMA(0, 0, At, B0); PG8_MMA(0, 1, At, B1); PG8_BAR; PG8_SCHED;
            PG8_LDA(At, 1, 1); PG8_STAGE(PG8_SB(1, 0), b3, voffB); PG8_STAGE(PG8_SB(1, 1), b3 + hstep, voffB); PG8_STAGE(PG8_SA(1, 0), a3, voffA);
            PG8_WAIT_V(8); PG8_WAIT_L(0); PG8_BAR; PG8_MMA(1, 0, At, B0); PG8_MMA(1, 1, At, B1); PG8_BAR; PG8_SCHED;
            } else {
            PG8_LDB(B0, 0, 0); PG8_SCHED; PG8_LDA(At, 0, 0); PG8_STAGE(PG8_SA(1, 1), a1 + hstep, voffA);
            PG8_WAIT_L(8); PG8_BAR; PG8_WAIT_L(0); PG8_MMA(0, 0, At, B0); PG8_BAR; PG8_SCHED;
            PG8_LDB(B1, 0, 1); PG8_STAGE(PG8_SB(0, 0), b2, voffB);
            PG8_BAR; PG8_WAIT_L(0); PG8_MMA(0, 1, At, B1); PG8_BAR;
            PG8_LDA(At, 0, 1); PG8_STAGE(PG8_SA(0, 0), a2, voffA);
            PG8_BAR; PG8_WAIT_L(0); PG8_MMA(1, 0, At, B0); PG8_BAR; PG8_SCHED;
            PG8_STAGE(PG8_SB(0, 1), b2 + hstep, voffB);
            PG8_WAIT_V(6); PG8_BAR; PG8_MMA(1, 1, At, B1); PG8_BAR;
            PG8_LDB(B0, 1, 0); PG8_SCHED; PG8_LDA(At, 1, 0); PG8_STAGE(PG8_SA(0, 1), a2 + hstep, voffA);
            PG8_WAIT_L(8); PG8_BAR; PG8_WAIT_L(0); PG8_MMA(0, 0, At, B0); PG8_BAR; PG8_SCHED;
            PG8_LDB(B1, 1, 1); PG8_STAGE(PG8_SB(1, 0), b3, voffB);
            PG8_BAR; PG8_WAIT_L(0); PG8_MMA(0, 1, At, B1); PG8_BAR;
            PG8_LDA(At, 1, 1); PG8_STAGE(PG8_SA(1, 0), a3, voffA);
            PG8_BAR; PG8_WAIT_L(0); PG8_MMA(1, 0, At, B0); PG8_BAR; PG8_SCHED;
            PG8_STAGE(PG8_SB(1, 1), b3 + hstep, voffB);
            PG8_WAIT_V(6); PG8_BAR; PG8_MMA(1, 1, At, B1); PG8_BAR;
            }
        }
        if constexpr (ALIGN_EPI) { if (wr == 0) PG8_BAR; }
        if constexpr (!Epi::AFTER_DRAIN) { E(acc, cur, wr, wc, fr, fq); S.done(cur); }
        if (!has_next) break;
#pragma unroll
        for (int a = 0; a < 2; ++a)
#pragma unroll
            for (int b = 0; b < 2; ++b)
#pragma unroll
                for (int m = 0; m < 4; ++m)
#pragma unroll
                    for (int n = 0; n < 2; ++n) acc[a][b][m][n] = (f32x4){0.f, 0.f, 0.f, 0.f};
        cur = nxt; cA = nA; cB = nB; ++ui;
        if constexpr (ALIGN_EPI) { if (wr == 1) PG8_BAR; }
    }
    PG8_WAIT_V(0);
    if constexpr (!ALIGN_EPI) { if (wr == 0) PG8_BAR; }
    PG8_BAR;
    if constexpr (Epi::AFTER_DRAIN) { E.fused(acc, cur, wr, wc, fr, fq, lds, wid, lane); S.done(cur); }
#undef PG8_SA
#undef PG8_SB
#undef PG8_STAGE
#undef PG8_LDA
#undef PG8_LDB
#undef PG8_MMA
#undef PG8_WAIT_V
#undef PG8_WAIT_L
#undef PG8_BAR
#undef PG8_SCHED
}
}
#define GAS __attribute__((address_space(1)))
#define LAS __attribute__((address_space(3)))
typedef unsigned short bf16;
typedef unsigned v4u __attribute__((ext_vector_type(4)));
typedef float f32x4 __attribute__((ext_vector_type(4)));
typedef short bf16x8 __attribute__((ext_vector_type(8)));
typedef GAS unsigned gu32;
typedef GAS unsigned long long gu64;
#define RLX_AGENT __ATOMIC_RELAXED, __HIP_MEMORY_SCOPE_AGENT
#define LDS_WAIT() asm volatile("s_waitcnt lgkmcnt(0)" ::: "memory")
#define VM_WAIT() asm volatile("s_waitcnt vmcnt(0)" ::: "memory")
__device__ __forceinline__ unsigned long long rt() { return __builtin_amdgcn_s_memrealtime(); }
__device__ __forceinline__ unsigned f2bf(float f) { unsigned u = __builtin_bit_cast(unsigned, f); return (u + 0x7fffu + ((u >> 16) & 1u)) >> 16; }
__device__ __forceinline__ unsigned pk2(float lo, float hi) { return f2bf(lo) | (f2bf(hi) << 16); }

#define XB_TMO      128
#define XB_XCNT(j)  (256  + 64 * (j))
#define XB_XSUB(j)  (1280 + 64 * (j))
#define XB_XGEN(j)  (2304 + 64 * (j))
#define XB_TOP      3328
#define XB_TOPGEN   3392
#define XCD_BAR_WORDS 3456
#define XB_SPIN_CAP (1u << 18)

__device__ __forceinline__ unsigned xb_ld(unsigned* p)              { return __hip_atomic_load(p, __ATOMIC_RELAXED, __HIP_MEMORY_SCOPE_AGENT); }
__device__ __forceinline__ unsigned xb_add(unsigned* p, unsigned v) { return __hip_atomic_fetch_add(p, v, __ATOMIC_RELAXED, __HIP_MEMORY_SCOPE_AGENT); }
__device__ __forceinline__ unsigned xb_xcc_id() { return (unsigned)__builtin_amdgcn_s_getreg((3 << 11) | 20) & 0xFu; }
#define XB_SPIN(cond, bar) do { unsigned _sp = 0; while (cond) { __builtin_amdgcn_s_sleep(1); \
    if ((++_sp & 255u) == 0u) { if (xb_ld(&(bar)[XB_TMO])) break; if (_sp > XB_SPIN_CAP) { atomicAdd(&(bar)[XB_TMO], 1u); break; } } } } while (0)

struct XcdBarrier {
    unsigned* bar; unsigned x;
    volatile LAS unsigned* st;
};

__device__ __forceinline__ XcdBarrier xcd_barrier_post(unsigned* bar, volatile LAS unsigned* st) {
    XcdBarrier b; b.bar = bar; b.x = xb_xcc_id(); b.st = st;
    if (threadIdx.x == 0) (void)xb_add(&bar[XB_XCNT(b.x)], 1u);
    return b;
}
__device__ __forceinline__ void xcd_barrier_complete(unsigned* bar, unsigned x, unsigned& nloc, unsigned& nx) {
    const unsigned G = gridDim.x * gridDim.y * gridDim.z;
    unsigned sum, cnt, mine, sp = 0u;
    for (;;) {
        sum = 0u; cnt = 0u; mine = 0u;
#pragma unroll
        for (unsigned j = 0; j < 16; ++j) { const unsigned c = xb_ld(&bar[XB_XCNT(j)]); sum += c; cnt += (c > 0u) ? 1u : 0u; mine = (j == x) ? c : mine; }
        if (sum == G) break;
        __builtin_amdgcn_s_sleep(1);
        if ((++sp & 255u) == 0u) { if (xb_ld(&bar[XB_TMO])) break; if (sp > XB_SPIN_CAP) { atomicAdd(&bar[XB_TMO], 1u); break; } }
    }
    nloc = mine > 0u ? mine : 1u; nx = cnt > 0u ? cnt : 1u;
}

__device__ __forceinline__ void xcd_barrier(const XcdBarrier& b) {
    asm volatile("s_waitcnt vmcnt(0)" ::: "memory");
    __syncthreads();
    if (threadIdx.x == 0) {
        unsigned* bar = b.bar;
        __builtin_amdgcn_s_waitcnt(0);
        unsigned nloc = b.st[0], nx = b.st[1];
        if (nloc == 0u) { xcd_barrier_complete(bar, b.x, nloc, nx); b.st[0] = nloc; b.st[1] = nx; }
        const unsigned old = xb_add(&bar[XB_XSUB(b.x)], 1u);
        const unsigned gen = old / nloc;
        if (old + 1u == (gen + 1u) * nloc) {
            __builtin_amdgcn_fence(__ATOMIC_RELEASE, "agent");
            asm volatile("s_waitcnt vmcnt(0)" ::: "memory");
            const unsigned og = xb_add(&bar[XB_TOP], 1u);
            const unsigned tg = og / nx;
            if (og + 1u == (tg + 1u) * nx) xb_add(&bar[XB_TOPGEN], 1u);
            else XB_SPIN(xb_ld(&bar[XB_TOPGEN]) == tg, bar);
            __builtin_amdgcn_fence(__ATOMIC_ACQUIRE, "agent");
            xb_add(&bar[XB_XGEN(b.x)], 1u);
            asm volatile("s_waitcnt vmcnt(0)" ::: "memory");
        } else {
            XB_SPIN(xb_ld(&bar[XB_XGEN(b.x)]) == gen, bar);
            __builtin_amdgcn_fence(__ATOMIC_ACQUIRE, "agent");
            asm volatile("s_waitcnt vmcnt(0)" ::: "memory");
        }
    }
    __syncthreads();
}

#ifndef MK_N_LAUNCHES
#define MK_N_LAUNCHES 1
#endif
#ifndef PROBE_EXTRA_MASK
#define PROBE_EXTRA_MASK 0
#endif
constexpr int N_PHASES = 11;
constexpr int N_LAUNCHES = MK_N_LAUNCHES;
constexpr int NWAVES = 8;
constexpr int NB = 8, SEQ = 2048, DM = 1024, MTOK = NB * SEQ;
constexpr float LN_EPS = 1e-5f;
constexpr float DN_ALPHA = 1.189207115002721f;
constexpr float LOG2E = 1.4426950408889634f;
constexpr float QSCALE = 0.125f * LOG2E;
constexpr float LAMBDA_INIT = 0.2f;
constexpr int MODS = 6 * DM;

constexpr size_t MiB = 1u << 20;
constexpr size_t WS_CTL = 0, CTL_ZERO_BYTES = 65536;
constexpr size_t WS_MOD = 1 * MiB;
constexpr size_t WS_WQK = 2 * MiB, WS_WV = 6 * MiB, WS_WO = 8 * MiB, WS_WC = 10 * MiB;
constexpr size_t WS_SDN = 1 * MiB + 256 * 1024, WS_SUP = 1 * MiB + 320 * 1024;
constexpr size_t WS_TDN = 16 * MiB, WS_TUP = 32 * MiB;
constexpr size_t WS_IDG = 48 * MiB, WS_CW = 64 * MiB;
constexpr size_t WS_H2 = 80 * MiB;
constexpr size_t WS_F = 112 * MiB;
constexpr size_t WS_XN = 112 * MiB, WS_QK = 144 * MiB, WS_VT = 208 * MiB;
constexpr size_t WS_CC = 112 * MiB, WS_Y = 144 * MiB, WS_ST = 112 * MiB;
constexpr size_t WS_END = 240 * MiB;
constexpr int CW_BAR = 1024;

constexpr int RING_BYTES = 131072;
constexpr int LDSCTL_OFF = RING_BYTES, MISC_OFF = LDSCTL_OFF + 320;
constexpr int LDS_BYTES = 147456;

typedef float f32x16 __attribute__((ext_vector_type(16)));
typedef float f32x2v __attribute__((ext_vector_type(2)));
typedef unsigned u32x2 __attribute__((ext_vector_type(2)));
typedef __bf16 bf16x2_t __attribute__((ext_vector_type(2)));

__device__ __forceinline__ unsigned cvtpk(float lo, float hi) { f32x2v v = {lo, hi}; bf16x2_t b = __builtin_convertvector(v, bf16x2_t); return __builtin_bit_cast(unsigned, b); }
__device__ __forceinline__ float bf_lo(unsigned w) { return __builtin_bit_cast(float, w << 16); }
__device__ __forceinline__ float bf_hi(unsigned w) { return __builtin_bit_cast(float, w & 0xffff0000u); }
__device__ __forceinline__ float wave_sum(float v) {
#pragma unroll
    for (int o = 1; o < 64; o <<= 1) v += __shfl_xor(v, o);
    return v;
}
__device__ __forceinline__ float dot2bf(unsigned w, unsigned x, float acc) { return __builtin_amdgcn_fdot2_f32_bf16(__builtin_bit_cast(bf16x2_t, w), __builtin_bit_cast(bf16x2_t, x), acc, false); }

__device__ __forceinline__ void phase_mod(const float* c, const float* w_ada, const float* b_ada, float* mod, unsigned char* lds, int tid, int lane, int wave) {
    float* sc = (float*)lds;
    float* red = (float*)(lds + 32768);
    bool did = false;
    for (int item = blockIdx.x; item < MODS / 64; item += gridDim.x) {
        if (!did) { for (int i = tid; i < NB * DM; i += 512) { const float v = c[i]; sc[i] = v / (1.f + __expf(-v)); } __syncthreads(); did = true; }
        const int e0 = item * 64, cg = lane & 15, rs = lane >> 4;
        float acc[8][4];
#pragma unroll
        for (int b = 0; b < 8; ++b) { acc[b][0] = 0.f; acc[b][1] = 0.f; acc[b][2] = 0.f; acc[b][3] = 0.f; }
#pragma unroll 4
        for (int it = 0; it < 32; ++it) {
            const int d = wave * 128 + it * 4 + rs;
            const f32x4 wv = *(const f32x4*)(w_ada + (size_t)d * MODS + e0 + 4 * cg);
#pragma unroll
            for (int b = 0; b < 8; ++b) { const float s = sc[b * DM + d]; acc[b][0] += s * wv[0]; acc[b][1] += s * wv[1]; acc[b][2] += s * wv[2]; acc[b][3] += s * wv[3]; }
        }
#pragma unroll
        for (int b = 0; b < 8; ++b)
#pragma unroll
            for (int j = 0; j < 4; ++j) { float v = acc[b][j]; v += __shfl_xor(v, 16); v += __shfl_xor(v, 32); if (rs == 0) red[(wave * 8 + b) * 64 + 4 * cg + j] = v; }
        __syncthreads();
        { const int b = tid >> 6, col = tid & 63; float s = b_ada[e0 + col];
#pragma unroll
          for (int w = 0; w < 8; ++w) s += red[(w * 8 + b) * 64 + col];
          mod[b * MODS + e0 + col] = s; }
        __syncthreads();
    }
}

__device__ __forceinline__ void transpose_item(const float* W, int ldw, int col0, int K, bf16* WT, int row_off, float scale, LAS float* scr, int kb, int nb, int lane) {
    const int k0 = 64 * kb, n0 = 32 * nb;
#pragma unroll 8
    for (int i = 0; i < 32; ++i) { const int kk = 2 * i + (lane >> 5); scr[kk * 33 + (lane & 31)] = W[(size_t)(k0 + kk) * ldw + col0 + n0 + (lane & 31)]; }
    LDS_WAIT(); asm volatile("" ::: "memory");
    const int c = lane & 7;
#pragma unroll
    for (int j = 0; j < 4; ++j) { const int n = (lane >> 3) + 8 * j; const LAS float* s = scr + (8 * c) * 33 + n;
        v4u o; o.x = cvtpk(s[0 * 33] * scale, s[1 * 33] * scale); o.y = cvtpk(s[2 * 33] * scale, s[3 * 33] * scale); o.z = cvtpk(s[4 * 33] * scale, s[5 * 33] * scale); o.w = cvtpk(s[6 * 33] * scale, s[7 * 33] * scale);
        *(v4u*)(WT + (size_t)(row_off + n0 + n) * K + k0 + 8 * c) = o; }
    LDS_WAIT(); asm volatile("" ::: "memory");
}
__device__ __forceinline__ bf16x8 ld8_f32_bf16(const float* p) {
    const f32x4 a = *(const f32x4*)p, b = *(const f32x4*)(p + 4);
    v4u o; o.x = cvtpk(a[0], a[1]); o.y = cvtpk(a[2], a[3]); o.z = cvtpk(b[0], b[1]); o.w = cvtpk(b[2], b[3]);
    return __builtin_bit_cast(bf16x8, o);
}
__device__ __forceinline__ void wc_item(const float* w_query, const float* sub_keys, bf16* WcT, int item, int lane) {
    const int hp = item >> 6, d0 = (item & 63) * 16, p = hp & 1;
    const int r = lane & 15, kg = lane >> 4;
    bf16x8 a[4];
#pragma unroll
    for (int ks = 0; ks < 4; ++ks) a[ks] = ld8_f32_bf16(w_query + (size_t)(d0 + r) * 2048 + hp * 128 + ks * 32 + 8 * kg);
#pragma unroll
    for (int nt = 0; nt < 8; ++nt) {
        f32x4 acc = {0.f, 0.f, 0.f, 0.f};
#pragma unroll
        for (int ks = 0; ks < 4; ++ks) { const bf16x8 b = ld8_f32_bf16(sub_keys + (size_t)(p * 128 + nt * 16 + r) * 128 + ks * 32 + 8 * kg);
            acc = __builtin_amdgcn_mfma_f32_16x16x32_bf16(a[ks], b, acc, 0, 0, 0); }
        u32x2 o; o.x = cvtpk(acc[0], acc[1]); o.y = cvtpk(acc[2], acc[3]);
        *(u32x2*)(WcT + (size_t)(hp * 128 + nt * 16 + r) * DM + d0 + 4 * kg) = o;
    }
}
struct RowStats { float mean, rstd; };
__device__ __forceinline__ RowStats row_stats(const f32x4 (&v)[4]) {
    float s = 0.f;
#pragma unroll
    for (int j = 0; j < 4; ++j) s += (v[j][0] + v[j][1]) + (v[j][2] + v[j][3]);
    const float mean = wave_sum(s) * (1.f / DM); float s2 = 0.f;
#pragma unroll
    for (int j = 0; j < 4; ++j) { const f32x4 d = v[j] - mean; s2 += (d[0] * d[0] + d[1] * d[1]) + (d[2] * d[2] + d[3] * d[3]); }
    RowStats r; r.mean = mean; r.rstd = 1.f / sqrtf(wave_sum(s2) * (1.f / DM) + LN_EPS); return r;
}
__device__ __forceinline__ void phase_prologue(const float* const* in, unsigned char* ws, LAS unsigned char* lds, int lane, int wave) {
    const float* x = in[0]; const float* w_in = in[4]; const float* w_out = in[5]; const float* w_query = in[15]; const float* sub_keys = in[16];
    const float* mod = (const float*)(ws + WS_MOD);
    LAS float* scr = (LAS float*)(lds + wave * 16384);
    const int gw = blockIdx.x * NWAVES + wave, NGW = gridDim.x * NWAVES;
    for (int it = gw; it < 2048; it += NGW) {
        const int seg = it >> 8, r = it & 255, kb = r >> 4, nb = r & 15;
        switch (seg) {
            case 0: transpose_item(w_in, 3072, 0, DM, (bf16*)(ws + WS_WQK), 0, QSCALE, scr, kb, nb, lane); break;
            case 1: transpose_item(w_in, 3072, 512, DM, (bf16*)(ws + WS_WQK), 512, 1.f, scr, kb, nb, lane); break;
            case 2: transpose_item(w_in, 3072, 1536, DM, (bf16*)(ws + WS_WQK), 1024, QSCALE, scr, kb, nb, lane); break;
            case 3: transpose_item(w_in, 3072, 2048, DM, (bf16*)(ws + WS_WQK), 1536, 1.f, scr, kb, nb, lane); break;
            case 4: transpose_item(w_in, 3072, 1024, DM, (bf16*)(ws + WS_WV), 0, 1.f, scr, kb, nb, lane); break;
            case 5: transpose_item(w_in, 3072, 2560, DM, (bf16*)(ws + WS_WV), 512, 1.f, scr, kb, nb, lane); break;
            case 6: transpose_item(w_out, 1024, 0, DM, (bf16*)(ws + WS_WO), 0, 1.f, scr, kb, nb, lane); break;
            default: transpose_item(w_out, 1024, 512, DM, (bf16*)(ws + WS_WO), 512, 1.f, scr, kb, nb, lane); break;
        }
    }
    for (int it = gw; it < 1024; it += NGW) wc_item(w_query, sub_keys, (bf16*)(ws + WS_WC), it, lane);
    for (int m = gw; m < MTOK; m += NGW) {
        const int b = m >> 11; const float* sh = mod + b * MODS; const float* scp = sh + DM;
        const f32x4* xr = (const f32x4*)(x + (size_t)m * DM) + lane;
        f32x4 v[4];
#pragma unroll
        for (int j = 0; j < 4; ++j) v[j] = xr[64 * j];
        const RowStats st = row_stats(v);
        u32x2* o8 = (u32x2*)((bf16*)(ws + WS_XN) + (size_t)m * DM) + lane;
#pragma unroll
        for (int j = 0; j < 4; ++j) { const f32x4 s4 = *((const f32x4*)scp + lane + 64 * j), h4 = *((const f32x4*)sh + lane + 64 * j);
            const f32x4 y = (v[j] - st.mean) * st.rstd * (s4 + 1.0f) + h4; u32x2 o; o.x = cvtpk(y[0], y[1]); o.y = cvtpk(y[2], y[3]); o8[64 * j] = o; }
    }
    for (int rr = gw; rr < 32768; rr += NGW) {
        const bool up = rr >= 16384; const int e = up ? rr - 16384 : rr;
        const float* src = (up ? in[18] : in[17]) + (size_t)e * DM + 16 * lane;
        f32x4 v[4]; float am = 0.f;
#pragma unroll
        for (int j = 0; j < 4; ++j) { v[j] = *(const f32x4*)(src + 4 * j); am = fmaxf(am, fmaxf(fmaxf(fabsf(v[j][0]), fabsf(v[j][1])), fmaxf(fabsf(v[j][2]), fabsf(v[j][3])))); }
#pragma unroll
        for (int o = 1; o < 64; o <<= 1) am = fmaxf(am, __shfl_xor(am, o));
        const float sc = am > 0.f ? 384.f / am : 1.f;
        v4u q;
        { int w = 0; w = __builtin_amdgcn_cvt_pk_fp8_f32(v[0][0] * sc, v[0][1] * sc, w, false); w = __builtin_amdgcn_cvt_pk_fp8_f32(v[0][2] * sc, v[0][3] * sc, w, true); q.x = (unsigned)w; }
        { int w = 0; w = __builtin_amdgcn_cvt_pk_fp8_f32(v[1][0] * sc, v[1][1] * sc, w, false); w = __builtin_amdgcn_cvt_pk_fp8_f32(v[1][2] * sc, v[1][3] * sc, w, true); q.y = (unsigned)w; }
        { int w = 0; w = __builtin_amdgcn_cvt_pk_fp8_f32(v[2][0] * sc, v[2][1] * sc, w, false); w = __builtin_amdgcn_cvt_pk_fp8_f32(v[2][2] * sc, v[2][3] * sc, w, true); q.z = (unsigned)w; }
        { int w = 0; w = __builtin_amdgcn_cvt_pk_fp8_f32(v[3][0] * sc, v[3][1] * sc, w, false); w = __builtin_amdgcn_cvt_pk_fp8_f32(v[3][2] * sc, v[3][3] * sc, w, true); q.w = (unsigned)w; }
        if (!up) { *(v4u*)(ws + WS_TDN + (size_t)e * DM + 16 * lane) = q; if (lane == 0) ((float*)(ws + WS_SDN))[e] = am > 0.f ? am * (1.f / 384.f) : 1.f; }
        else { *(v4u*)(ws + WS_TUP + ((size_t)(lane >> 3) * 16384 + e) * 128 + 16 * (lane & 7)) = q; if (lane == 0) ((float*)(ws + WS_SUP))[e] = am > 0.f ? am * (1.f / 384.f) : 1.f; }
    }
}

constexpr int ATT_KSTR = 144, ATT_VSTR = 136;
constexpr int ATT_K0 = 0, ATT_K1 = 64 * ATT_KSTR, ATT_V = 2 * 64 * ATT_KSTR, ATT_BUF = ATT_V + 128 * ATT_VSTR;
constexpr int ATT_TAB = 98304;
constexpr int ATT_RPB_N = 8 * 15 * 31, ATT_T5_N = 4 * 257;
static_assert(2 * ATT_BUF <= 65536 + 8192 && ATT_TAB + (ATT_RPB_N + ATT_T5_N + 4) * 4 <= RING_BYTES, "attention LDS map");

__device__ __forceinline__ int t5_bucket(int rel) {
    const int n = rel < 0 ? -rel : rel; int bucket = rel > 0 ? 16 : 0;
    const float nf = (float)(n < 1 ? 1 : n);
    int large = 8 + (int)(logf(nf / 8.0f) / 2.772588722239781f * 8.0f);
    large = large < 15 ? large : 15;
    return bucket + (n < 8 ? n : large);
}
__device__ __forceinline__ void att_tables(const float* na_rpb, const float* t5_bias, const float* lq1, const float* lk1, const float* lq2, const float* lk2, unsigned char* lds, int tid, int lane, int wave) {
    float* rpbL = (float*)(lds + ATT_TAB); float* t5L = rpbL + ATT_RPB_N; float* lamL = t5L + ATT_T5_N;
    for (int i = tid; i < ATT_RPB_N; i += 512) rpbL[i] = na_rpb[i] * LOG2E;
    for (int i = tid; i < ATT_T5_N; i += 512) { const int h = i / 257, rel = i % 257 - 128; t5L[i] = t5_bias[t5_bucket(rel) * 4 + h] * LOG2E; }
    if (wave == 0) { const float a = wave_sum(lq1[lane] * lk1[lane]), b = wave_sum(lq2[lane] * lk2[lane]); if (lane == 0) lamL[0] = expf(a) - expf(b) + LAMBDA_INIT; }
    __syncthreads();
}

__device__ __forceinline__ void na_item(int item, const bf16* QK, const bf16* VT, bf16* CC, const float* rpbL, int lane) {
    const int g = item & 3, r = (item >> 2) & 31, h = (item >> 7) & 7, b = item >> 10;
    const int qi = lane & 15, kg = lane >> 4;
    const int rs = min(max(r - 4, 0), 24);
    const int c0 = (g == 0) ? 0 : (g == 1) ? 8 : (g == 2) ? 24 : 32;
    const int qcol = 16 * g + qi, cs = min(max(qcol - 8, 0), 48);
    const size_t tokb = (size_t)b * SEQ;
    const bf16* qp = QK + (tokb + r * 64 + qcol) * 2048 + h * 64 + 8 * kg;
    const bf16x8 qf0 = *(const bf16x8*)qp, qf1 = *(const bf16x8*)(qp + 32);
    f32x4 s[16];
#pragma unroll
    for (int t = 0; t < 16; ++t) {
        const int i = t >> 1, half = t & 1;
        const bf16* kp = QK + (tokb + (rs + i) * 64 + c0 + 16 * half + qi) * 2048 + 512 + h * 64 + 8 * kg;
        const bf16x8 k0 = *(const bf16x8*)kp, k1 = *(const bf16x8*)(kp + 32);
        f32x4 a = {0.f, 0.f, 0.f, 0.f};
        a = __builtin_amdgcn_mfma_f32_16x16x32_bf16(k0, qf0, a, 0, 0, 0);
        a = __builtin_amdgcn_mfma_f32_16x16x32_bf16(k1, qf1, a, 0, 0, 0);
        s[t] = a;
    }
    float mx = -INFINITY;
#pragma unroll
    for (int t = 0; t < 16; ++t) {
        const int i = t >> 1, half = t & 1; const float* bp = rpbL + (h * 15 + (rs + i - r + 7)) * 31 + 15;
#pragma unroll
        for (int e = 0; e < 4; ++e) { const int kcol = c0 + 16 * half + 4 * kg + e; const bool valid = (kcol >= cs) && (kcol < cs + 16);
            const int co = min(max(kcol - qcol, -15), 15);
            const float v = valid ? s[t][e] + bp[co] : -INFINITY; s[t][e] = v; mx = fmaxf(mx, v); }
    }
    mx = fmaxf(mx, __shfl_xor(mx, 16)); mx = fmaxf(mx, __shfl_xor(mx, 32));
    float l = 0.f;
#pragma unroll
    for (int t = 0; t < 16; ++t)
#pragma unroll
        for (int e = 0; e < 4; ++e) { const float p = __builtin_amdgcn_exp2f(s[t][e] - mx); s[t][e] = p; l += p; }
    l += __shfl_xor(l, 16); l += __shfl_xor(l, 32);
    f32x4 o[4];
#pragma unroll
    for (int nt = 0; nt < 4; ++nt) o[nt] = (f32x4){0.f, 0.f, 0.f, 0.f};
#pragma unroll
    for (int kk = 0; kk < 8; ++kk) {
        v4u pw; pw.x = cvtpk(s[2 * kk][0], s[2 * kk][1]); pw.y = cvtpk(s[2 * kk][2], s[2 * kk][3]); pw.z = cvtpk(s[2 * kk + 1][0], s[2 * kk + 1][1]); pw.w = cvtpk(s[2 * kk + 1][2], s[2 * kk + 1][3]);
        const bf16x8 pb = __builtin_bit_cast(bf16x8, pw);
#pragma unroll
        for (int nt = 0; nt < 4; ++nt) {
            const bf16* vp = VT + (size_t)(h * 64 + nt * 16 + qi) * MTOK + tokb + (rs + kk) * 64 + c0 + 4 * kg;
            const u32x2 lo = *(const u32x2*)vp, hi = *(const u32x2*)(vp + 16);
            v4u aw; aw.x = lo.x; aw.y = lo.y; aw.z = hi.x; aw.w = hi.y;
            o[nt] = __builtin_amdgcn_mfma_f32_16x16x32_bf16(__builtin_bit_cast(bf16x8, aw), pb, o[nt], 0, 0, 0);
        }
    }
    const float inv = 1.f / l;
    bf16* op = CC + (tokb + r * 64 + qcol) * DM + h * 64 + 4 * kg;
#pragma unroll
    for (int nt = 0; nt < 4; ++nt) { u32x2 w; w.x = cvtpk(o[nt][0] * inv, o[nt][1] * inv); w.y = cvtpk(o[nt][2] * inv, o[nt][3] * inv); *(u32x2*)(op + nt * 16) = w; }
}

__device__ __forceinline__ int crow(int r, int hi) { return (r & 3) + 8 * (r >> 2) + 4 * hi; }

__device__ __forceinline__ void diff_unit(int unit, const bf16* QK, const bf16* VT, bf16* CC, const float* subln, unsigned char* lds, int tid, int lane, int wave) {
    const int qb = unit & 15, h = (unit >> 4) & 3, b = unit >> 6;
    const int mp = wave >> 2, qs = wave & 3, r32 = lane & 31, hi = lane >> 5;
    const size_t tokb = (size_t)b * SEQ;
    const int q0 = qb * 128 + qs * 32;
    const float* t5L = (const float*)(lds + ATT_TAB) + ATT_RPB_N + h * 257 + 128;
    const float lam = ((const float*)(lds + ATT_TAB))[ATT_RPB_N + ATT_T5_N];
    const float cL = t5L[-128], cR = t5L[128];
    bf16x8 qf[4];
    { const bf16* qp = QK + (tokb + q0 + r32) * 2048 + 1024 + h * 128 + mp * 64 + 8 * hi;
#pragma unroll
      for (int d0 = 0; d0 < 4; ++d0) qf[d0] = *(const bf16x8*)(qp + d0 * 16); }
    const bf16* ksrc = QK + (tokb + (tid >> 3)) * 2048 + 1536 + h * 128 + (tid & 7) * 8;
    const bf16* vsrc = VT + (size_t)(512 + h * 128 + (tid >> 3)) * MTOK + tokb + (tid & 7) * 8;
    const int kdst = (tid >> 3) * ATT_KSTR + (tid & 7) * 16, vdst = ATT_V + (tid >> 3) * ATT_VSTR + (tid & 7) * 16;
    v4u sk[2], sv[2];
#define DIFF_LOAD(t) do { sk[0] = *(const v4u*)(ksrc + (size_t)(t) * 64 * 2048); sk[1] = *(const v4u*)(ksrc + (size_t)(t) * 64 * 2048 + 64); \
        sv[0] = *(const v4u*)(vsrc + (t) * 64); sv[1] = *(const v4u*)(vsrc + (size_t)64 * MTOK + (t) * 64); } while (0)
#define DIFF_STORE(buf) do { unsigned char* bb_ = lds + (buf) * ATT_BUF; *(v4u*)(bb_ + ATT_K0 + kdst) = sk[0]; *(v4u*)(bb_ + ATT_K1 + kdst) = sk[1]; \
        *(u32x2*)(bb_ + vdst) = (u32x2){sv[0].x, sv[0].y}; *(u32x2*)(bb_ + vdst + 8) = (u32x2){sv[0].z, sv[0].w}; \
        *(u32x2*)(bb_ + vdst + 64 * ATT_VSTR) = (u32x2){sv[1].x, sv[1].y}; *(u32x2*)(bb_ + vdst + 64 * ATT_VSTR + 8) = (u32x2){sv[1].z, sv[1].w}; } while (0)
    DIFF_LOAD(0); DIFF_STORE(0); __syncthreads();
    f32x16 o[4];
#pragma unroll
    for (int k = 0; k < 4; ++k)
#pragma unroll
        for (int e = 0; e < 16; ++e) o[k][e] = 0.f;
    float m_run = -1e30f, l_run = 0.f;
    const int qpos = q0 + r32;
    for (int t = 0; t < SEQ / 64; ++t) {
        if (t + 1 < SEQ / 64) DIFF_LOAD(t + 1);
        const unsigned char* bb = lds + (t & 1) * ATT_BUF;
        const unsigned char* kb_ = bb + (mp ? ATT_K1 : ATT_K0) + r32 * ATT_KSTR + hi * 16;
        const bool farL = (64 * t + 63 - q0) <= -91, farR = (64 * t - (q0 + 31)) >= 91;
        const float cinit = farL ? cL : (farR ? cR : 0.f);
        f32x16 p0, p1;
#pragma unroll
        for (int e = 0; e < 16; ++e) { p0[e] = cinit; p1[e] = cinit; }
#pragma unroll
        for (int d0 = 0; d0 < 4; ++d0) {
            const bf16x8 ka = *(const bf16x8*)(kb_ + d0 * 32), kc = *(const bf16x8*)(kb_ + 32 * ATT_KSTR + d0 * 32);
            p0 = __builtin_amdgcn_mfma_f32_32x32x16_bf16(ka, qf[d0], p0, 0, 0, 0);
            p1 = __builtin_amdgcn_mfma_f32_32x32x16_bf16(kc, qf[d0], p1, 0, 0, 0);
        }
        if (!(farL || farR)) {
            const int rel0 = 64 * t - qpos;
#pragma unroll
            for (int e = 0; e < 16; ++e) { const int ra = rel0 + crow(e, hi); const int rb = ra + 32;
                p0[e] += t5L[min(max(ra, -128), 128)]; p1[e] += t5L[min(max(rb, -128), 128)]; }
        }
        float mx = p0[0];
#pragma unroll
        for (int e = 1; e < 16; ++e) mx = fmaxf(mx, p0[e]);
#pragma unroll
        for (int e = 0; e < 16; ++e) mx = fmaxf(mx, p1[e]);
        mx = fmaxf(mx, __shfl_xor(mx, 32));
        const float m_new = fmaxf(m_run, mx), alpha = __builtin_amdgcn_exp2f(m_run - m_new);
        m_run = m_new;
        float ls = 0.f;
#pragma unroll
        for (int e = 0; e < 16; ++e) { p0[e] = __builtin_amdgcn_exp2f(p0[e] - m_new); p1[e] = __builtin_amdgcn_exp2f(p1[e] - m_new); ls += p0[e] + p1[e]; }
        l_run = l_run * alpha + ls;
#pragma unroll
        for (int k = 0; k < 4; ++k)
#pragma unroll
            for (int e = 0; e < 16; ++e) o[k][e] *= alpha;
        bf16x8 pf[4];
        { v4u w;
          w.x = cvtpk(p0[0], p0[1]); w.y = cvtpk(p0[2], p0[3]); w.z = cvtpk(p0[4], p0[5]); w.w = cvtpk(p0[6], p0[7]); pf[0] = __builtin_bit_cast(bf16x8, w);
          w.x = cvtpk(p0[8], p0[9]); w.y = cvtpk(p0[10], p0[11]); w.z = cvtpk(p0[12], p0[13]); w.w = cvtpk(p0[14], p0[15]); pf[1] = __builtin_bit_cast(bf16x8, w);
          w.x = cvtpk(p1[0], p1[1]); w.y = cvtpk(p1[2], p1[3]); w.z = cvtpk(p1[4], p1[5]); w.w = cvtpk(p1[6], p1[7]); pf[2] = __builtin_bit_cast(bf16x8, w);
          w.x = cvtpk(p1[8], p1[9]); w.y = cvtpk(p1[10], p1[11]); w.z = cvtpk(p1[12], p1[13]); w.w = cvtpk(p1[14], p1[15]); pf[3] = __builtin_bit_cast(bf16x8, w); }
        const unsigned char* vb_ = bb + ATT_V + r32 * ATT_VSTR + hi * 8;
#pragma unroll
        for (int blk = 0; blk < 4; ++blk)
#pragma unroll
            for (int ks = 0; ks < 4; ++ks) {
                const unsigned char* vp = vb_ + blk * 32 * ATT_VSTR + ks * 32;
                const u32x2 lo = *(const u32x2*)vp, hv = *(const u32x2*)(vp + 16);
                v4u aw; aw.x = lo.x; aw.y = lo.y; aw.z = hv.x; aw.w = hv.y;
                o[blk] = __builtin_amdgcn_mfma_f32_32x32x16_bf16(__builtin_bit_cast(bf16x8, aw), pf[ks], o[blk], 0, 0, 0);
            }
        if (t + 1 < SEQ / 64) DIFF_STORE((t + 1) & 1);
        __syncthreads();
    }
#undef DIFF_LOAD
#undef DIFF_STORE
    const float ltot = l_run + __shfl_xor(l_run, 32);
    const float inv = (mp ? lam : 1.f) / ltot;
    float* exch = (float*)lds + qs * 4096;
    if (mp == 1) {
#pragma unroll
        for (int k = 0; k < 4; ++k)
#pragma unroll
            for (int e = 0; e < 16; ++e) exch[(k * 16 + e) * 64 + lane] = o[k][e] * inv;
    }
    __syncthreads();
    if (mp == 0) {
        float ss = 0.f;
#pragma unroll
        for (int k = 0; k < 4; ++k)
#pragma unroll
            for (int e = 0; e < 16; ++e) { const float d = o[k][e] * inv - exch[(k * 16 + e) * 64 + lane]; o[k][e] = d; ss += d * d; }
        ss += __shfl_xor(ss, 32);
        const float rn = (1.0f - LAMBDA_INIT) / sqrtf(ss * (1.f / 128.f) + LN_EPS);
        bf16* op = CC + (tokb + q0 + r32) * DM + 512 + h * 128 + 4 * hi;
#pragma unroll
        for (int k = 0; k < 4; ++k)
#pragma unroll
            for (int g4 = 0; g4 < 4; ++g4) { const int dv = k * 32 + 8 * g4 + 4 * hi; const f32x4 sg = *(const f32x4*)(subln + dv);
                u32x2 w; w.x = cvtpk(o[k][4 * g4] * rn * sg[0], o[k][4 * g4 + 1] * rn * sg[1]); w.y = cvtpk(o[k][4 * g4 + 2] * rn * sg[2], o[k][4 * g4 + 3] * rn * sg[3]);
                *(u32x2*)(op + k * 32 + 8 * g4) = w; }
    }
    __syncthreads();
}

__device__ __forceinline__ void phase_attention(const float* const* in, unsigned char* ws, unsigned char* lds, int tid, int lane, int wave) {
    const bf16* QK = (const bf16*)(ws + WS_QK); const bf16* VT = (const bf16*)(ws + WS_VT); bf16* CC = (bf16*)(ws + WS_CC);
    att_tables(in[6], in[7], in[8], in[9], in[10], in[11], lds, tid, lane, wave);
    for (int u = blockIdx.x; u < 512; u += gridDim.x) diff_unit(u, QK, VT, CC, in[12], lds, tid, lane, wave);
    const float* rpbL = (const float*)(lds + ATT_TAB);
    const int gw = blockIdx.x * NWAVES + wave, NGW = gridDim.x * NWAVES;
    for (int it = gw; it < 8192; it += NGW) na_item(it, QK, VT, CC, rpbL, lane);
}

__device__ __forceinline__ void phase_rows(const float* const* in, unsigned char* ws, float* X1, int lane, int wave) {
    const float* Y = (const float*)(ws + WS_Y); const float* mod = (const float*)(ws + WS_MOD); bf16* H2 = (bf16*)(ws + WS_H2);
    const float* g1 = in[13]; const float* b1 = in[14];
    const int gw = blockIdx.x * NWAVES + wave, NGW = gridDim.x * NWAVES;
    for (int m = gw; m < MTOK; m += NGW) {
        const int b = m >> 11; const float* sh = mod + b * MODS + 3 * DM; const float* scp = mod + b * MODS + 4 * DM;
        const f32x4* yr = (const f32x4*)(Y + (size_t)m * DM) + lane;
        f32x4 v[4];
#pragma unroll
        for (int j = 0; j < 4; ++j) v[j] = yr[64 * j];
        const RowStats s1 = row_stats(v);
        f32x4* xo = (f32x4*)(X1 + (size_t)m * DM) + lane;
#pragma unroll
        for (int j = 0; j < 4; ++j) { const f32x4 gg = *((const f32x4*)g1 + lane + 64 * j), bb = *((const f32x4*)b1 + lane + 64 * j);
            v[j] = (v[j] - s1.mean) * s1.rstd * gg + bb; xo[64 * j] = v[j]; }
        const RowStats s2 = row_stats(v);
        u32x2* o8 = (u32x2*)(H2 + (size_t)m * DM) + lane;
#pragma unroll
        for (int j = 0; j < 4; ++j) { const f32x4 s4 = *((const f32x4*)scp + lane + 64 * j), h4 = *((const f32x4*)sh + lane + 64 * j);
            const f32x4 y = (v[j] - s2.mean) * s2.rstd * (s4 + 1.0f) + h4; u32x2 o; o.x = cvtpk(y[0], y[1]); o.y = cvtpk(y[2], y[3]); o8[64 * j] = o; }
    }
}

__device__ __forceinline__ unsigned key_enc(float v, int n) { const unsigned u = __builtin_bit_cast(unsigned, v); const unsigned k = u ^ (((int)u >> 31) | 0x80000000u); return (k & ~127u) | (unsigned)(127 - n); }
__device__ __forceinline__ float key_val(unsigned k) { k &= ~127u; const unsigned u = (k & 0x80000000u) ? (k ^ 0x80000000u) : ~k; return __builtin_bit_cast(float, u); }
__device__ __forceinline__ int key_idx(unsigned k) { return 127 - (int)(k & 127u); }
__device__ __forceinline__ float gelu_erf(float x) { return 0.5f * x * (1.f + erff(x * 0.70710678118654752f)); }

constexpr int PE_TOK = 64;
constexpr int PE_ID = 0, PE_G = 32768;
__device__ __forceinline__ void phase_topk(unsigned char* ws, unsigned char* lds, int tid, int lane, int wave) {
    const float* ST = (const float*)(ws + WS_ST); u32x2* IDG = (u32x2*)(ws + WS_IDG);
    int* idL = (int*)(lds + PE_ID); float* gL = (float*)(lds + PE_G);
    for (int tile = blockIdx.x; tile < MTOK / PE_TOK; tile += gridDim.x) {
        const int tok0 = tile * PE_TOK;
        {
            unsigned tk[2][16];
#pragma unroll
            for (int p = 0; p < 2; ++p) {
#pragma unroll
                for (int i = 0; i < 16; ++i) tk[p][i] = 0u;
                const float* sp = ST + (size_t)(wave * 256 + p * 128) * MTOK + tok0 + lane;
#pragma unroll 8
                for (int n = 0; n < 128; ++n) {
                    unsigned v = key_enc(sp[(size_t)n * MTOK], n);
#pragma unroll
                    for (int i = 0; i < 16; ++i) { const unsigned hi_ = max(tk[p][i], v); v = min(tk[p][i], v); tk[p][i] = hi_; }
                }
            }
            float bv[16]; int bi[16];
#pragma unroll
            for (int i = 0; i < 16; ++i) { bv[i] = -INFINITY; bi[i] = 0; }
#pragma unroll
            for (int i = 0; i < 16; ++i)
#pragma unroll
                for (int j = 0; j < 16; ++j) if ((i + 1) * (j + 1) <= 16) {
                    float v = key_val(tk[0][i]) + key_val(tk[1][j]); int id = key_idx(tk[0][i]) * 128 + key_idx(tk[1][j]);
#pragma unroll
                    for (int k = 0; k < 16; ++k) { const bool c = v > bv[k]; const float nv = c ? bv[k] : v; const int ni = c ? bi[k] : id; bv[k] = c ? v : bv[k]; bi[k] = c ? id : bi[k]; v = nv; id = ni; }
                }
            float sum = 0.f; const float bmax = bv[0];
#pragma unroll
            for (int k = 0; k < 16; ++k) { bv[k] = __expf(bv[k] - bmax); sum += bv[k]; }
            const float rinv = 1.f / sum;
#pragma unroll
            for (int k = 0; k < 16; ++k) { idL[(wave * 16 + k) * 64 + lane] = bi[k]; gL[(wave * 16 + k) * 64 + lane] = bv[k] * rinv; }
        }
        __syncthreads();
#pragma unroll
        for (int i = 0; i < 8; ++i) { const int tl = wave * 8 + i;
#pragma unroll
            for (int hf = 0; hf < 2; ++hf) { const int e = lane + 64 * hf; u32x2 pr; pr.x = (unsigned)idL[e * 64 + tl]; pr.y = __builtin_bit_cast(unsigned, gL[e * 64 + tl]); IDG[(size_t)(tok0 + tl) * 128 + e] = pr; } }
        __syncthreads();
    }
}

__device__ __forceinline__ float wave_sum_u(float v) {
    v += __builtin_bit_cast(float, __builtin_amdgcn_update_dpp(0, __builtin_bit_cast(int, v), 0xB1, 0xf, 0xf, false));
    v += __builtin_bit_cast(float, __builtin_amdgcn_update_dpp(0, __builtin_bit_cast(int, v), 0x4E, 0xf, 0xf, false));
    v += __builtin_bit_cast(float, __builtin_amdgcn_update_dpp(0, __builtin_bit_cast(int, v), 0x141, 0xf, 0xf, false));
    v += __builtin_bit_cast(float, __builtin_amdgcn_update_dpp(0, __builtin_bit_cast(int, v), 0x140, 0xf, 0xf, false));
    v += __builtin_bit_cast(float, __builtin_amdgcn_update_dpp(0, __builtin_bit_cast(int, v), 0x142, 0xa, 0xf, false));
    v += __builtin_bit_cast(float, __builtin_amdgcn_update_dpp(0, __builtin_bit_cast(int, v), 0x143, 0xc, 0xf, false));
    return __builtin_bit_cast(float, __builtin_amdgcn_readlane(__builtin_bit_cast(int, v), 63));
}
struct SliceMap { int n_x, rank; unsigned own; };
__device__ __forceinline__ SliceMap slice_setup(unsigned* bar, unsigned x, volatile LAS unsigned* st, int tid) {
    if (N_LAUNCHES == 1) {
        if (tid == 0) {
            unsigned np = 0, mi = 0, mine = 1;
#pragma unroll
            for (unsigned j = 0; j < 16; ++j) { const unsigned c = xb_ld(&bar[XB_XCNT(j)]); if (c > 0u) { if (j == x) { mi = np; mine = c; } ++np; } }
            if (np == 0u) np = 1u;
            unsigned mask = 0u;
#pragma unroll
            for (unsigned sl = 0; sl < 8; ++sl) if (sl % np == mi) mask |= 1u << sl;
            st[3] = mine; st[4] = mask;
        }
        __syncthreads();
        SliceMap m; m.n_x = (int)st[3]; m.rank = (int)st[2]; m.own = st[4]; return m;
    } else { SliceMap m; m.n_x = gridDim.x / 8; m.rank = blockIdx.x >> 3; m.own = 1u << (blockIdx.x & 7); return m; }
}
__device__ __forceinline__ f32x2v fp8x2(unsigned w, bool hi) { return hi ? __builtin_amdgcn_cvt_pk_f32_fp8((int)w, true) : __builtin_amdgcn_cvt_pk_f32_fp8((int)w, false); }

__device__ __forceinline__ void phase_down(unsigned char* ws, const SliceMap sm, int lane, int wave) {
    const u32x2* IDG = (const u32x2*)(ws + WS_IDG); u32x2* CW = (u32x2*)(ws + WS_CW); const bf16* H2 = (const bf16*)(ws + WS_H2);
    const unsigned char* TDN = ws + WS_TDN; const float* SDN = (const float*)(ws + WS_SDN); const float* SUP = (const float*)(ws + WS_SUP);
    const int gwx = sm.rank * NWAVES + wave, nwx = sm.n_x * NWAVES;
    for (int s = 0; s < 8; ++s) {
        if (!((sm.own >> s) & 1u)) continue;
        for (int t = gwx; t < MTOK; t += nwx) {
            const u32x2 p0 = IDG[(size_t)t * 128 + lane], p1 = IDG[(size_t)t * 128 + 64 + lane];
            float hx[16];
            { const v4u* hp = (const v4u*)(H2 + (size_t)t * DM + 16 * lane); const v4u h0 = hp[0], h1 = hp[1];
              hx[0] = bf_lo(h0.x); hx[1] = bf_hi(h0.x); hx[2] = bf_lo(h0.y); hx[3] = bf_hi(h0.y); hx[4] = bf_lo(h0.z); hx[5] = bf_hi(h0.z); hx[6] = bf_lo(h0.w); hx[7] = bf_hi(h0.w);
              hx[8] = bf_lo(h1.x); hx[9] = bf_hi(h1.x); hx[10] = bf_lo(h1.y); hx[11] = bf_hi(h1.y); hx[12] = bf_lo(h1.z); hx[13] = bf_hi(h1.z); hx[14] = bf_lo(h1.w); hx[15] = bf_hi(h1.w); }
            unsigned long long m0 = __ballot((int)(p0.x >> 11) == s), m1 = __ballot((int)(p1.x >> 11) == s);
            while (m0 | m1) {
                int ej[8]; bool vj[8];
#pragma unroll
                for (int j = 0; j < 8; ++j) {
                    if (m0) { ej[j] = __builtin_ctzll(m0); m0 &= m0 - 1; vj[j] = true; }
                    else if (m1) { ej[j] = 64 + __builtin_ctzll(m1); m1 &= m1 - 1; vj[j] = true; }
                    else { ej[j] = ej[j > 0 ? j - 1 : 0]; vj[j] = false; }
                }
                v4u q[8]; int rowj[8]; float gj[8];
#pragma unroll
                for (int j = 0; j < 8; ++j) {
                    const int e = ej[j];
                    rowj[j] = (e < 64) ? __builtin_amdgcn_readlane((int)p0.x, e & 63) : __builtin_amdgcn_readlane((int)p1.x, e & 63);
                    gj[j] = __builtin_bit_cast(float, (e < 64) ? __builtin_amdgcn_readlane((int)p0.y, e & 63) : __builtin_amdgcn_readlane((int)p1.y, e & 63));
                    q[j] = *(const v4u*)(TDN + (size_t)rowj[j] * DM + 16 * lane);
                }
                float xv = 0.f, gv = 0.f; int idv = 0, ev = 0; bool okv = false;
#pragma unroll
                for (int j = 0; j < 8; ++j) {
                    f32x2v a = {0.f, 0.f}, b2 = {0.f, 0.f};
                    { const f32x2v c0 = fp8x2(q[j].x, false), c1 = fp8x2(q[j].x, true); a += c0 * (f32x2v){hx[0], hx[1]}; b2 += c1 * (f32x2v){hx[2], hx[3]}; }
                    { const f32x2v c0 = fp8x2(q[j].y, false), c1 = fp8x2(q[j].y, true); a += c0 * (f32x2v){hx[4], hx[5]}; b2 += c1 * (f32x2v){hx[6], hx[7]}; }
                    { const f32x2v c0 = fp8x2(q[j].z, false), c1 = fp8x2(q[j].z, true); a += c0 * (f32x2v){hx[8], hx[9]}; b2 += c1 * (f32x2v){hx[10], hx[11]}; }
                    { const f32x2v c0 = fp8x2(q[j].w, false), c1 = fp8x2(q[j].w, true); a += c0 * (f32x2v){hx[12], hx[13]}; b2 += c1 * (f32x2v){hx[14], hx[15]}; }
                    const float tot = wave_sum_u((a[0] + a[1]) + (b2[0] + b2[1]));
                    const float sd = SDN[rowj[j]], su = SUP[rowj[j]];
                    const bool me = lane == j;
                    xv = me ? tot * sd : xv; gv = me ? gj[j] * su : gv; idv = me ? rowj[j] : idv; ev = me ? ej[j] : ev; okv = me ? vj[j] : okv;
                }
                if (lane < 8 && okv) { u32x2 pr; pr.x = (unsigned)idv; pr.y = __builtin_bit_cast(unsigned, gv * gelu_erf(xv)); CW[(size_t)t * 128 + ev] = pr; }
            }
        }
    }
}

__device__ __forceinline__ void phase_up(unsigned char* ws, const SliceMap sm, int lane, int wave) {
    const f32x2v* CW = (const f32x2v*)(ws + WS_CW); const unsigned char* TUP = ws + WS_TUP; float* F = (float*)(ws + WS_F);
    const int gwx = sm.rank * NWAVES + wave, nwx = sm.n_x * NWAVES;
    const int eg = lane >> 3, cs = lane & 7;
    for (int s = 0; s < 8; ++s) {
        if (!((sm.own >> s) & 1u)) continue;
        const unsigned char* tb = TUP + (size_t)s * 16384 * 128 + 16 * cs;
        for (int t = gwx; t < MTOK; t += nwx) {
            f32x2v pr[16];
#pragma unroll
            for (int i = 0; i < 16; ++i) pr[i] = CW[(size_t)t * 128 + 8 * i + eg];
            v4u q[16];
#pragma unroll
            for (int i = 0; i < 16; ++i) q[i] = *(const v4u*)(tb + (size_t)__builtin_bit_cast(unsigned, pr[i].x) * 128);
            f32x2v acc[8];
#pragma unroll
            for (int k = 0; k < 8; ++k) acc[k] = (f32x2v){0.f, 0.f};
#pragma unroll
            for (int i = 0; i < 16; ++i) { const float w = pr[i].y;
                acc[0] += fp8x2(q[i].x, false) * w; acc[1] += fp8x2(q[i].x, true) * w; acc[2] += fp8x2(q[i].y, false) * w; acc[3] += fp8x2(q[i].y, true) * w;
                acc[4] += fp8x2(q[i].z, false) * w; acc[5] += fp8x2(q[i].z, true) * w; acc[6] += fp8x2(q[i].w, false) * w; acc[7] += fp8x2(q[i].w, true) * w; }
#pragma unroll
            for (int k = 0; k < 8; ++k)
#pragma unroll
                for (int c = 0; c < 2; ++c) { float v = acc[k][c]; v += __shfl_xor(v, 8); v += __shfl_xor(v, 16); v += __shfl_xor(v, 32); acc[k][c] = v; }
            if (eg == 0) { float* fp = F + (size_t)t * DM + 128 * s + 16 * cs;
#pragma unroll
                for (int k = 0; k < 4; ++k) *(f32x4*)(fp + 4 * k) = (f32x4){acc[2 * k][0], acc[2 * k][1], acc[2 * k + 1][0], acc[2 * k + 1][1]}; }
        }
    }
}

__device__ __forceinline__ void phase_final(const float* const* in, unsigned char* ws, float* OUT, int lane, int wave) {
    const float* F = (const float*)(ws + WS_F); const float* mod = (const float*)(ws + WS_MOD); const float* g2 = in[19]; const float* b2 = in[20];
    const int gw = blockIdx.x * NWAVES + wave, NGW = gridDim.x * NWAVES;
    for (int m = gw; m < MTOK; m += NGW) {
        const int b = m >> 11; const float* gf = mod + b * MODS + 5 * DM;
        f32x4* xr = (f32x4*)(OUT + (size_t)m * DM) + lane; const f32x4* fr = (const f32x4*)(F + (size_t)m * DM) + lane;
        f32x4 v[4];
#pragma unroll
        for (int j = 0; j < 4; ++j) { const f32x4 gg = *((const f32x4*)gf + lane + 64 * j); v[j] = xr[64 * j] * DN_ALPHA + (gg + 1.0f) * fr[64 * j]; }
        const RowStats st = row_stats(v);
#pragma unroll
        for (int j = 0; j < 4; ++j) { const f32x4 gg = *((const f32x4*)g2 + lane + 64 * j), bb = *((const f32x4*)b2 + lane + 64 * j); xr[64 * j] = (v[j] - st.mean) * st.rstd * gg + bb; }
    }
}

struct Args { const float* in[21]; float* out; unsigned char* ws; int ph_lo, ph_hi; };
__global__ void __launch_bounds__(NWAVES * 64, 2) fwd_kernel(Args args) {
    extern __shared__ __attribute__((aligned(16))) unsigned char lds[];
    LAS unsigned char* ldsl = (LAS unsigned char*)lds;
    const int tid = threadIdx.x, lane = tid & 63, wave = __builtin_amdgcn_readfirstlane(tid >> 6);
    const int G = gridDim.x;
    unsigned char* ws = args.ws;
    gu32* ctl = (gu32*)(ws + WS_CTL);
    for (int u = tid; u < (LDS_BYTES - LDSCTL_OFF) / 4; u += NWAVES * 64) ((LAS unsigned*)(ldsl + LDSCTL_OFF))[u] = 0u;
    __syncthreads();
    XcdBarrier bar; bar.bar = (unsigned*)(ctl + CW_BAR); bar.x = 0; bar.st = nullptr;
    volatile LAS unsigned* bst = (volatile LAS unsigned*)(ldsl + MISC_OFF) + 8;
    if (N_LAUNCHES == 1) { bar.bar = (unsigned*)(ctl + CW_BAR); bar.x = xb_xcc_id(); bar.st = bst; if (tid == 0) bst[2] = xb_add(&bar.bar[XB_XCNT(bar.x)], 1u); }
    const int lo = args.ph_lo, hi = args.ph_hi;
#define IN(k) (lo <= (k) && (k) < hi)
#define SEAM(k) do { if (IN(k) && IN((k) + 1)) xcd_barrier(bar); } while (0)

    if (IN(0)) { phase_mod(args.in[1], args.in[2], args.in[3], (float*)(ws + WS_MOD), lds, tid, lane, wave); }
    SEAM(0);
    if (IN(1)) { phase_prologue(args.in, ws, ldsl, lane, wave); }
    SEAM(1);
    if (IN(2)) {
        { pg8::Gemm g{(const bf16*)(ws + WS_XN), (const bf16*)(ws + WS_WQK), MTOK, 2048, DM}; pg8::StaticOrder S; S.init(MTOK, 2048, G, (int)blockIdx.x);
          pg8::EpiBf16 E{(bf16*)(ws + WS_QK), 2048};
          pg8::gemm_phase<pg8::EpiBf16, pg8::StaticOrder, true, true>(ldsl, g, S, E); }
        __syncthreads();
        { pg8::Gemm g{(const bf16*)(ws + WS_WV), (const bf16*)(ws + WS_XN), 1024, MTOK, DM}; pg8::StaticOrder S; S.init(1024, MTOK, G, (int)blockIdx.x);
          pg8::EpiBf16 E{(bf16*)(ws + WS_VT), MTOK};
          pg8::gemm_phase<pg8::EpiBf16, pg8::StaticOrder, true, true>(ldsl, g, S, E); }
    }
    SEAM(2);
    if (IN(3)) { __syncthreads(); phase_attention(args.in, ws, lds, tid, lane, wave); }
    SEAM(3);
    if (IN(4)) {
        pg8::Gemm g{(const bf16*)(ws + WS_CC), (const bf16*)(ws + WS_WO), MTOK, DM, DM}; pg8::StaticOrder S; S.init(MTOK, DM, G, (int)blockIdx.x);
        pg8::EpiY E{args.in[0], (const float*)(ws + WS_MOD) + 2 * DM, MODS, (float*)(ws + WS_Y), DN_ALPHA};
        pg8::gemm_phase<pg8::EpiY, pg8::StaticOrder, true, true>(ldsl, g, S, E);
    }
    SEAM(4);
    if (IN(5)) { phase_rows(args.in, ws, args.out, lane, wave); }
    SEAM(5);
    if (IN(6)) {
        pg8::Gemm g{(const bf16*)(ws + WS_WC), (const bf16*)(ws + WS_H2), 2048, MTOK, DM}; pg8::StaticOrder S; S.init(2048, MTOK, G, (int)blockIdx.x);
        pg8::EpiF32 E{(float*)(ws + WS_ST), MTOK};
        pg8::gemm_phase<pg8::EpiF32, pg8::StaticOrder, true, true>(ldsl, g, S, E);
    }
    SEAM(6);
    if (IN(7)) { __syncthreads(); phase_topk(ws, lds, tid, lane, wave); }
    SEAM(7);
    if (IN(8)) { const SliceMap sm = slice_setup((unsigned*)(ctl + CW_BAR), bar.x, bst, tid); phase_down(ws, sm, lane, wave); }
    SEAM(8);
    if (IN(9)) { const SliceMap sm = slice_setup((unsigned*)(ctl + CW_BAR), bar.x, bst, tid); phase_up(ws, sm, lane, wave); }
    SEAM(9);
    if (IN(10)) { phase_final(args.in, ws, args.out, lane, wave); }
#undef IN
#undef SEAM
}

extern "C" void kernel_launch(void* const* d_in, const int* in_sizes, int n_in, void* d_out, int out_size, void* d_ws, size_t ws_size, hipStream_t stream) {
    static int grid = 0;
    if (grid == 0) {
        if (n_in != 21 || out_size != MTOK * DM || ws_size < WS_END) { fprintf(stderr, "kernel_launch: unexpected shapes (n_in %d out %d ws %zu)\n", n_in, out_size, ws_size); grid = -1; return; }
        int dev = 0, cus = 0, per_cu = 0;
        if (hipGetDevice(&dev) != hipSuccess || hipDeviceGetAttribute(&cus, hipDeviceAttributeMultiprocessorCount, dev) != hipSuccess) { grid = -1; return; }
        if (hipFuncSetAttribute((const void*)fwd_kernel, hipFuncAttributeMaxDynamicSharedMemorySize, LDS_BYTES) != hipSuccess) { fprintf(stderr, "kernel_launch: hipFuncSetAttribute failed\n"); grid = -1; return; }
        if (hipOccupancyMaxActiveBlocksPerMultiprocessor(&per_cu, (const void*)fwd_kernel, NWAVES * 64, LDS_BYTES) != hipSuccess || per_cu < 1) { fprintf(stderr, "kernel_launch: occupancy query says %d\n", per_cu); }
        (void)hipGetLastError();
        grid = cus;
    }
    if (grid < 0) return;
    if (hipMemsetAsync((char*)d_ws + WS_CTL, 0, CTL_ZERO_BYTES, stream) != hipSuccess) return;
    Args a{};
    for (int i = 0; i < 21; ++i) a.in[i] = (const float*)d_in[i];
    a.out = (float*)d_out; a.ws = (unsigned char*)d_ws;
    if (N_LAUNCHES == 1) { a.ph_lo = 0; a.ph_hi = N_PHASES; hipLaunchKernelGGL(fwd_kernel, dim3(grid), dim3(NWAVES * 64), LDS_BYTES, stream, a); }
    else { for (int p = 0; p < N_PHASES; ++p) { a.ph_lo = p; a.ph_hi = p + 1; hipLaunchKernelGGL(fwd_kernel, dim3(grid), dim3(NWAVES * 64), LDS_BYTES, stream, a); } }
    if (PROBE_EXTRA_MASK) { for (int p = 0; p < N_PHASES; ++p) if ((PROBE_EXTRA_MASK >> p) & 1) { a.ph_lo = p; a.ph_hi = p + 1; hipLaunchKernelGGL(fwd_kernel, dim3(grid), dim3(NWAVES * 64), LDS_BYTES, stream, a); } }
}
```

```cpp
#include <hip/hip_runtime.h>
#include <hip/hip_bf16.h>
#include <cstdio>
#include <cstdint>
#include <cmath>
namespace pg8 {
#define PG8_LAS __attribute__((address_space(3)))
typedef unsigned short bf16_t;
typedef short bf16x8 __attribute__((ext_vector_type(8)));
typedef float f32x4 __attribute__((ext_vector_type(4)));
typedef unsigned u32x4 __attribute__((ext_vector_type(4)));
constexpr int BM = 256, BK = 64, HALF = 128, HTB = HALF * BK * 2  , STAGE_BYTES = 8 * HTB, NXCD = 8, WGM = 8;

__host__ __device__ __forceinline__ int lds_byte(int r, int c) { const int st = (r >> 4) * 2 + (c >> 5), rr = r & 15, cc = c & 31, ob = rr * 64 + cc * 2; return st * 1024 + (ob ^ (((ob >> 9) & 1) << 5)); }
__host__ __device__ __forceinline__ void stage_rc(int b, int& R, int& C) { const int st = b / 1024, sb = b % 1024, swz = sb ^ (((sb >> 9) & 1) << 5); R = (st >> 1) * 16 + swz / 64; C = (st & 1) * 32 + (swz % 64) / 2; }
__host__ __device__ __forceinline__ int perm32(int rho) { const int n = rho >> 4, i = rho & 15; return 8 * (i >> 2) + 4 * n + (i & 3); }

struct Unit { int pm, pn; };
struct Gemm { const bf16_t* A; const bf16_t* Bt; int M, N, K; };

struct StaticOrder {
    int nM, nN, nwg, G, c;
    __host__ __device__ void init(int M, int N, int G_, int c_) { nM = M / BM; nN = N / BM; nwg = nM * nN; G = G_; c = c_; }
    __host__ __device__ bool next(int i, Unit& u) const {
        const long L = (long)i * G + c; if (L >= nwg) return false;
        int wgid = (int)L; { const int q = nwg / NXCD, r = nwg % NXCD, xcd = wgid % NXCD, off = wgid / NXCD; wgid = (xcd < r ? xcd * (q + 1) : r * (q + 1) + (xcd - r) * q) + off; }
        const int nig = WGM * nN, gid = wgid / nig, fm = gid * WGM, gsz = (nM - fm) < WGM ? (nM - fm) : WGM;
        u.pm = fm + ((wgid % nig) % gsz); u.pn = (wgid % nig) / gsz; return true;
    }
    __device__ __forceinline__ void a_ready(const Unit&) const {}
    __device__ __forceinline__ void done(const Unit&) const {}
};

__device__ __forceinline__ unsigned cvt_pk_bf16(float lo, float hi) { unsigned r; asm volatile("v_cvt_pk_bf16_f32 %0, %1, %2" : "=v"(r) : "v"(lo), "v"(hi)); return r; }
typedef float f32x2 __attribute__((ext_vector_type(2)));
struct EpiBf16 {
    static constexpr bool PERM = true, AFTER_DRAIN = false;
    bf16_t* O; int ldc;
    __device__ __forceinline__ void operator()(const f32x4 (&acc)[2][2][4][2], const Unit& u, int wr, int wc, int fr, int fq) const {
        const int row0 = u.pm * BM + wr * 64 + fr; const int col0 = u.pn * BM + wc * 32 + 8 * fq;
#pragma unroll
        for (int ai = 0; ai < 2; ++ai)
#pragma unroll
            for (int m = 0; m < 4; ++m) { bf16_t* rowp = O + (size_t)(row0 + ai * HALF + m * 16) * ldc + col0;
#pragma unroll
                for (int bj = 0; bj < 2; ++bj) { const f32x4 v0 = acc[ai][bj][m][0], v1 = acc[ai][bj][m][1];
                    u32x4 w; w.x = cvt_pk_bf16(v0[0], v0[1]); w.y = cvt_pk_bf16(v0[2], v0[3]); w.z = cvt_pk_bf16(v1[0], v1[1]); w.w = cvt_pk_bf16(v1[2], v1[3]);
                    *(u32x4*)(rowp + bj * HALF) = w; } }
    }
};
struct EpiF32 {
    static constexpr bool PERM = false, AFTER_DRAIN = false;
    float* O; int ldc;
    __device__ __forceinline__ void operator()(const f32x4 (&acc)[2][2][4][2], const Unit& u, int wr, int wc, int fr, int fq) const {
        const int row0 = u.pm * BM + wr * 64 + fr; const int col0 = u.pn * BM + wc * 32 + 4 * fq;
#pragma unroll
        for (int ai = 0; ai < 2; ++ai)
#pragma unroll
            for (int m = 0; m < 4; ++m) { float* rowp = O + (size_t)(row0 + ai * HALF + m * 16) * ldc + col0;
#pragma unroll
                for (int bj = 0; bj < 2; ++bj)
#pragma unroll
                    for (int n = 0; n < 2; ++n) *(f32x4*)(rowp + bj * HALF + n * 16) = acc[ai][bj][m][n]; }
    }
};
struct EpiY {
    static constexpr bool PERM = false, AFTER_DRAIN = false;
    const float* X; const float* gate;   int gstride; float* Y; float alpha;
    __device__ __forceinline__ void operator()(const f32x4 (&acc)[2][2][4][2], const Unit& u, int wr, int wc, int fr, int fq) const {
        const int row0 = u.pm * BM + wr * 64 + fr; const int col0 = u.pn * BM + wc * 32 + 4 * fq;
        const float* gp = gate + (size_t)((u.pm * BM) >> 11) * gstride + col0;
        f32x4 gv[2][2];
#pragma unroll
        for (int bj = 0; bj < 2; ++bj)
#pragma unroll
            for (int n = 0; n < 2; ++n) gv[bj][n] = *(const f32x4*)(gp + bj * HALF + n * 16) + 1.0f;
#pragma unroll
        for (int ai = 0; ai < 2; ++ai)
#pragma unroll
            for (int m = 0; m < 4; ++m) { const size_t off = (size_t)(row0 + ai * HALF + m * 16) * 1024 + col0;
#pragma unroll
                for (int bj = 0; bj < 2; ++bj)
#pragma unroll
                    for (int n = 0; n < 2; ++n) { const f32x4 xv = *(const f32x4*)(X + off + bj * HALF + n * 16);
                        *(f32x4*)(Y + off + bj * HALF + n * 16) = xv * alpha + gv[bj][n] * acc[ai][bj][m][n]; } }
    }
};

template <class Epi, class Sched, bool ALIGN_EPI = false, bool SP2 = false>
__device__ __forceinline__ void gemm_phase(PG8_LAS unsigned char* lds, const Gemm g, const Sched& S, const Epi& E) {
    const int tid = threadIdx.x, wid = __builtin_amdgcn_readfirstlane(tid >> 6), lane = tid & 63, wr = wid >> 2, wc = wid & 3, fr = lane & 15, fq = lane >> 4;
    const int K = g.K, nt = K / BK;
    unsigned voffA[2], voffB[2];
#pragma unroll
    for (int i = 0; i < 2; ++i) { int R, C; stage_rc(tid * 16 + i * 8192, R, C); const int Rb = Epi::PERM ? ((R & ~31) + perm32(R & 31)) : R;
        voffA[i] = (unsigned)(R * K + C) * 2u; voffB[i] = (unsigned)(Rb * K + C) * 2u; }
    const size_t kstep = (size_t)(BK * 2);
    const size_t hstep = (size_t)HALF * K * 2;
    const size_t tstep = 2 * hstep;
    const unsigned ldsw = (unsigned)wid * 1024u;
    const int aoff = lds_byte(wr * 64 + fr, fq * 8), boff = lds_byte(wc * 32 + fr, fq * 8);
#define PG8_SA(b, h) (((b) * 2 + (h)) * HTB)
#define PG8_SB(b, h) ((4 + (b) * 2 + (h)) * HTB)
#define PG8_STAGE(bufoff, gbase, voff) do { _Pragma("unroll") for (int _i = 0; _i < 2; ++_i) \
        __builtin_amdgcn_global_load_lds((const unsigned*)((const char*)(gbase) + (voff)[_i]), (PG8_LAS unsigned*)(lds + (bufoff) + ldsw + _i * 8192), 16, 0, 0); } while (0)
#define PG8_LDA(dst, b, h) do { _Pragma("unroll") for (int m = 0; m < 4; ++m) _Pragma("unroll") for (int k = 0; k < 2; ++k) dst[m][k] = *(const PG8_LAS bf16x8*)(lds + PG8_SA(b, h) + aoff + m * 2048 + k * 1024); } while (0)
#define PG8_LDB(dst, b, h) do { _Pragma("unroll") for (int n = 0; n < 2; ++n) _Pragma("unroll") for (int k = 0; k < 2; ++k) dst[n][k] = *(const PG8_LAS bf16x8*)(lds + PG8_SB(b, h) + boff + n * 2048 + k * 1024); } while (0)
#define PG8_MMA(ai, bj, At, Bt) do { __builtin_amdgcn_s_setprio(1); _Pragma("unroll") for (int m = 0; m < 4; ++m) _Pragma("unroll") for (int n = 0; n < 2; ++n) _Pragma("unroll") for (int k = 0; k < 2; ++k) \
        acc[ai][bj][m][n] = __builtin_amdgcn_mfma_f32_16x16x32_bf16(Bt[n][k], At[m][k], acc[ai][bj][m][n], 0, 0, 0); __builtin_amdgcn_s_setprio(0); } while (0)
#define PG8_WAIT_V(n) asm volatile("s_waitcnt vmcnt(" #n ")" ::: "memory")
#define PG8_WAIT_L(n) asm volatile("s_waitcnt lgkmcnt(" #n ")" ::: "memory")
#define PG8_BAR __builtin_amdgcn_s_barrier()
#define PG8_SCHED __builtin_amdgcn_sched_barrier(0)
    Unit cur, nxt; int ui = 0;
    if (!S.next(0, cur)) return;
    f32x4 acc[2][2][4][2];
#pragma unroll
    for (int a = 0; a < 2; ++a)
#pragma unroll
        for (int b = 0; b < 2; ++b)
#pragma unroll
            for (int m = 0; m < 4; ++m)
#pragma unroll
                for (int n = 0; n < 2; ++n) acc[a][b][m][n] = (f32x4){0.f, 0.f, 0.f, 0.f};
    bf16x8 At[4][2], B0[2][2], B1[2][2];
    const char* cA = (const char*)g.A + (size_t)cur.pm * tstep; const char* cB = (const char*)g.Bt + (size_t)cur.pn * tstep;
    S.a_ready(cur);
    if constexpr (SP2) {
        PG8_STAGE(PG8_SB(0, 0), cB, voffB); PG8_STAGE(PG8_SB(0, 1), cB + hstep, voffB); PG8_STAGE(PG8_SA(0, 0), cA, voffA); PG8_STAGE(PG8_SA(0, 1), cA + hstep, voffA);
        if (wr == 1) PG8_BAR;
        PG8_WAIT_V(2); PG8_BAR;
        PG8_STAGE(PG8_SB(1, 0), cB + kstep, voffB); PG8_STAGE(PG8_SA(1, 0), cA + kstep, voffA); PG8_STAGE(PG8_SB(1, 1), cB + hstep + kstep, voffB);
        PG8_WAIT_V(6); PG8_BAR;
    } else {
        PG8_STAGE(PG8_SB(0, 0), cB, voffB); PG8_STAGE(PG8_SA(0, 0), cA, voffA); PG8_STAGE(PG8_SB(0, 1), cB + hstep, voffB); PG8_STAGE(PG8_SA(0, 1), cA + hstep, voffA);
        if (wr == 1) PG8_BAR;
        PG8_WAIT_V(4); PG8_BAR;
        PG8_STAGE(PG8_SB(1, 0), cB + kstep, voffB); PG8_STAGE(PG8_SA(1, 0), cA + kstep, voffA); PG8_STAGE(PG8_SB(1, 1), cB + hstep + kstep, voffB);
        PG8_WAIT_V(6); PG8_BAR;
    }
    for (;;) {
        const bool has_next = S.next(ui + 1, nxt);
        const char* nA = has_next ? (const char*)g.A + (size_t)nxt.pm * tstep : cA; const char* nB = has_next ? (const char*)g.Bt + (size_t)nxt.pn * tstep : cB;
        for (int t = 0; t < nt; t += 2) {
            const bool last = (t == nt - 2);
            const char* a1 = cA + (size_t)(t + 1) * kstep;
            const char* a2 = last ? nA : cA + (size_t)(t + 2) * kstep; const char* b2 = last ? nB : cB + (size_t)(t + 2) * kstep;
            const char* a3 = a2 + kstep; const char* b3 = b2 + kstep;
            if (last && has_next) S.a_ready(nxt);
            if constexpr (SP2) {
            PG8_LDB(B0, 0, 0); PG8_LDB(B1, 0, 1); PG8_SCHED; PG8_LDA(At, 0, 0); PG8_STAGE(PG8_SA(1, 1), a1 + hstep, voffA);
            PG8_WAIT_V(8); PG8_WAIT_L(0); PG8_BAR; PG8_MMA(0, 0, At, B0); PG8_MMA(0, 1, At, B1); PG8_BAR; PG8_SCHED;
            PG8_LDA(At, 0, 1); PG8_STAGE(PG8_SB(0, 0), b2, voffB); PG8_STAGE(PG8_SB(0, 1), b2 + hstep, voffB); PG8_STAGE(PG8_SA(0, 0), a2, voffA);
            PG8_WAIT_V(8); PG8_WAIT_L(0); PG8_BAR; PG8_MMA(1, 0, At, B0); PG8_MMA(1, 1, At, B1); PG8_BAR; PG8_SCHED;
            PG8_LDB(B0, 1, 0); PG8_LDB(B1, 1, 1); PG8_SCHED; PG8_LDA(At, 1, 0); PG8_STAGE(PG8_SA(0, 1), a2 + hstep, voffA);
            PG8_WAIT_V(8); PG8_WAIT_L(0); PG8_BAR; PG8_MMA(0, 0, At, B0); PG8_MMA(0, 1, At, B1); PG8_BAR; PG8_SCHED;
            PG8_LDA(At, 1, 1); PG8_STAGE(PG8_SB(1, 0), b3, voffB); PG8_STAGE(PG8_SB(1, 1), b3 + hstep, voffB); PG8_STAGE(PG8_SA(1, 0), a3, voffA);
            PG8_WAIT_V(8); PG8_WAIT_L(0); PG8_BAR; PG8_MMA(1, 0, At, B0); PG8_MMA(1, 1, At, B1); PG8_BAR; PG8_SCHED;
            } else {
            PG8_LDB(B0, 0, 0); PG8_SCHED; PG8_LDA(At, 0, 0); PG8_STAGE(PG8_SA(1, 1), a1 + hstep, voffA);
            PG8_WAIT_L(8); PG8_BAR; PG8_WAIT_L(0); PG8_MMA(0, 0, At, B0); PG8_BAR; PG8_SCHED;
            PG8_LDB(B1, 0, 1); PG8_STAGE(PG8_SB(0, 0), b2, voffB);
            PG8_BAR; PG8_WAIT_L(0); PG8_MMA(0, 1, At, B1); PG8_BAR;
            PG8_LDA(At, 0, 1); PG8_STAGE(PG8_SA(0, 0), a2, voffA);
            PG8_BAR; PG8_WAIT_L(0); PG8_MMA(1, 0, At, B0); PG8_BAR; PG8_SCHED;
            PG8_STAGE(PG8_SB(0, 1), b2 + hstep, voffB);
            PG8_WAIT_V(6); PG8_BAR; PG8_MMA(1, 1, At, B1); PG8_BAR;
            PG8_LDB(B0, 1, 0); PG8_SCHED; PG8_LDA(At, 1, 0); PG8_STAGE(PG8_SA(0, 1), a2 + hstep, voffA);
            PG8_WAIT_L(8); PG8_BAR; PG8_WAIT_L(0); PG8_MMA(0, 0, At, B0); PG8_BAR; PG8_SCHED;
            PG8_LDB(B1, 1, 1); PG8_STAGE(PG8_SB(1, 0), b3, voffB);
            PG8_BAR; PG8_WAIT_L(0); PG8_MMA(0, 1, At, B1); PG8_BAR;
            PG8_LDA(At, 1, 1); PG8_STAGE(PG8_SA(1, 0), a3, voffA);
            PG8_BAR; PG8_WAIT_L(0); PG8_MMA(1, 0, At, B0); PG8_BAR; PG8_SCHED;
            PG8_STAGE(PG8_SB(1, 1), b3 + hstep, voffB);
            PG8_WAIT_V(6); PG8_BAR; PG8_MMA(1, 1, At, B1); PG8_BAR;
            }
        }
        if constexpr (ALIGN_EPI) { if (wr == 0) PG8_BAR; }
        if constexpr (!Epi::AFTER_DRAIN) { E(acc, cur, wr, wc, fr, fq); S.done(cur); }
        if (!has_next) break;
#pragma unroll
        for (int a = 0; a < 2; ++a)
#pragma unroll
            for (int b = 0; b < 2; ++b)
#pragma unroll
                for (int m = 0; m < 4; ++m)
#pragma unroll
                    for (int n = 0; n < 2; ++n) acc[a][b][m][n] = (f32x4){0.f, 0.f, 0.f, 0.f};
        cur = nxt; cA = nA; cB = nB; ++ui;
        if constexpr (ALIGN_EPI) { if (wr == 1) PG8_BAR; }
    }
    PG8_WAIT_V(0);
    if constexpr (!ALIGN_EPI) { if (wr == 0) PG8_BAR; }
    PG8_BAR;
    if constexpr (Epi::AFTER_DRAIN) { E.fused(acc, cur, wr, wc, fr, fq, lds, wid, lane); S.done(cur); }
#undef PG8_SA
#undef PG8_SB
#undef PG8_STAGE
#undef PG8_LDA
#undef PG8_LDB
#undef PG8_MMA
#undef PG8_WAIT_V
#undef PG8_WAIT_L
#undef PG8_BAR
#undef PG8_SCHED
}
}
#define GAS __attribute__((address_space(1)))
#define LAS __attribute__((address_space(3)))
typedef unsigned short bf16;
typedef unsigned v4u __attribute__((ext_vector_type(4)));
typedef float f32x4 __attribute__((ext_vector_type(4)));
typedef short bf16x8 __attribute__((ext_vector_type(8)));
typedef GAS unsigned gu32;
typedef GAS unsigned long long gu64;
#define RLX_AGENT __ATOMIC_RELAXED, __HIP_MEMORY_SCOPE_AGENT
#define LDS_WAIT() asm volatile("s_waitcnt lgkmcnt(0)" ::: "memory")
#define VM_WAIT() asm volatile("s_waitcnt vmcnt(0)" ::: "memory")
__device__ __forceinline__ unsigned long long rt() { return __builtin_amdgcn_s_memrealtime(); }
__device__ __forceinline__ unsigned f2bf(float f) { unsigned u = __builtin_bit_cast(unsigned, f); return (u + 0x7fffu + ((u >> 16) & 1u)) >> 16; }
__device__ __forceinline__ unsigned pk2(float lo, float hi) { return f2bf(lo) | (f2bf(hi) << 16); }

#define XB_TMO      128
#define XB_XCNT(j)  (256  + 64 * (j))
#define XB_XSUB(j)  (1280 + 64 * (j))
#define XB_XGEN(j)  (2304 + 64 * (j))
#define XB_TOP      3328
#define XB_TOPGEN   3392
#define XCD_BAR_WORDS 3456
#define XB_SPIN_CAP (1u << 18)

__device__ __forceinline__ unsigned xb_ld(unsigned* p)              { return __hip_atomic_load(p, __ATOMIC_RELAXED, __HIP_MEMORY_SCOPE_AGENT); }
__device__ __forceinline__ unsigned xb_add(unsigned* p, unsigned v) { return __hip_atomic_fetch_add(p, v, __ATOMIC_RELAXED, __HIP_MEMORY_SCOPE_AGENT); }
__device__ __forceinline__ unsigned xb_xcc_id() { return (unsigned)__builtin_amdgcn_s_getreg((3 << 11) | 20) & 0xFu; }
#define XB_SPIN(cond, bar) do { unsigned _sp = 0; while (cond) { __builtin_amdgcn_s_sleep(1); \
    if ((++_sp & 255u) == 0u) { if (xb_ld(&(bar)[XB_TMO])) break; if (_sp > XB_SPIN_CAP) { atomicAdd(&(bar)[XB_TMO], 1u); break; } } } } while (0)

struct XcdBarrier {
    unsigned* bar; unsigned x;
    volatile LAS unsigned* st;
};

__device__ __forceinline__ XcdBarrier xcd_barrier_post(unsigned* bar, volatile LAS unsigned* st) {
    XcdBarrier b; b.bar = bar; b.x = xb_xcc_id(); b.st = st;
    if (threadIdx.x == 0) (void)xb_add(&bar[XB_XCNT(b.x)], 1u);
    return b;
}
__device__ __forceinline__ void xcd_barrier_complete(unsigned* bar, unsigned x, unsigned& nloc, unsigned& nx) {
    const unsigned G = gridDim.x * gridDim.y * gridDim.z;
    unsigned sum, cnt, mine, sp = 0u;
    for (;;) {
        sum = 0u; cnt = 0u; mine = 0u;
#pragma unroll
        for (unsigned j = 0; j < 16; ++j) { const unsigned c = xb_ld(&bar[XB_XCNT(j)]); sum += c; cnt += (c > 0u) ? 1u : 0u; mine = (j == x) ? c : mine; }
        if (sum == G) break;
        __builtin_amdgcn_s_sleep(1);
        if ((++sp & 255u) == 0u) { if (xb_ld(&bar[XB_TMO])) break; if (sp > XB_SPIN_CAP) { atomicAdd(&bar[XB_TMO], 1u); break; } }
    }
    nloc = mine > 0u ? mine : 1u; nx = cnt > 0u ? cnt : 1u;
}

__device__ __forceinline__ void xcd_barrier(const XcdBarrier& b) {
    asm volatile("s_waitcnt vmcnt(0)" ::: "memory");
    __syncthreads();
    if (threadIdx.x == 0) {
        unsigned* bar = b.bar;
        __builtin_amdgcn_s_waitcnt(0);
        unsigned nloc = b.st[0], nx = b.st[1];
        if (nloc == 0u) { xcd_barrier_complete(bar, b.x, nloc, nx); b.st[0] = nloc; b.st[1] = nx; }
        const unsigned old = xb_add(&bar[XB_XSUB(b.x)], 1u);
        const unsigned gen = old / nloc;
        if (old + 1u == (gen + 1u) * nloc) {
            __builtin_amdgcn_fence(__ATOMIC_RELEASE, "agent");
            asm volatile("s_waitcnt vmcnt(0)" ::: "memory");
            const unsigned og = xb_add(&bar[XB_TOP], 1u);
            const unsigned tg = og / nx;
            if (og + 1u == (tg + 1u) * nx) xb_add(&bar[XB_TOPGEN], 1u);
            else XB_SPIN(xb_ld(&bar[XB_TOPGEN]) == tg, bar);
            __builtin_amdgcn_fence(__ATOMIC_ACQUIRE, "agent");
            xb_add(&bar[XB_XGEN(b.x)], 1u);
            asm volatile("s_waitcnt vmcnt(0)" ::: "memory");
        } else {
            XB_SPIN(xb_ld(&bar[XB_XGEN(b.x)]) == gen, bar);
            __builtin_amdgcn_fence(__ATOMIC_ACQUIRE, "agent");
            asm volatile("s_waitcnt vmcnt(0)" ::: "memory");
        }
    }
    __syncthreads();
}

#ifndef MK_N_LAUNCHES
#define MK_N_LAUNCHES 1
#endif
#ifndef PROBE_EXTRA_MASK
#define PROBE_EXTRA_MASK 0
#endif
constexpr int N_PHASES = 12;
constexpr int N_LAUNCHES = MK_N_LAUNCHES;
constexpr int NWAVES = 8;
constexpr int NB = 8, SEQ = 2048, DM = 1024, MTOK = NB * SEQ;
constexpr float LN_EPS = 1e-5f;
constexpr float DN_ALPHA = 1.189207115002721f;
constexpr float LOG2E = 1.4426950408889634f;
constexpr float QSCALE = 0.125f * LOG2E;
constexpr float LAMBDA_INIT = 0.2f;
constexpr int MODS = 6 * DM;

constexpr size_t MiB = 1u << 20;
constexpr size_t WS_CTL = 0, CTL_ZERO_BYTES = 65536;
constexpr size_t WS_MOD = 1 * MiB;
constexpr size_t WS_WQK = 2 * MiB, WS_WV = 6 * MiB, WS_WO = 8 * MiB, WS_WC = 10 * MiB;
constexpr size_t WS_SDN = 1 * MiB + 256 * 1024, WS_SUP = 1 * MiB + 320 * 1024;
constexpr size_t WS_TDN = 16 * MiB, WS_TUP = 32 * MiB;
constexpr size_t WS_IDG = 48 * MiB, WS_CW = 64 * MiB;
constexpr size_t WS_H2 = 80 * MiB;
constexpr size_t WS_P = 176 * MiB;
constexpr size_t WS_F = 112 * MiB;
constexpr size_t WS_XN = 112 * MiB, WS_QK = 144 * MiB, WS_VT = 208 * MiB;
constexpr size_t WS_CC = 112 * MiB, WS_Y = 144 * MiB, WS_ST = 112 * MiB;
constexpr size_t WS_END = 240 * MiB;
constexpr int CW_BAR = 1024;

constexpr int RING_BYTES = 131072;
constexpr int LDSCTL_OFF = RING_BYTES, MISC_OFF = LDSCTL_OFF + 320;
constexpr int LDS_BYTES = 147456;

typedef float f32x16 __attribute__((ext_vector_type(16)));
typedef float f32x2v __attribute__((ext_vector_type(2)));
typedef unsigned u32x2 __attribute__((ext_vector_type(2)));
typedef __bf16 bf16x2_t __attribute__((ext_vector_type(2)));

__device__ __forceinline__ unsigned cvtpk(float lo, float hi) { f32x2v v = {lo, hi}; bf16x2_t b = __builtin_convertvector(v, bf16x2_t); return __builtin_bit_cast(unsigned, b); }
__device__ __forceinline__ float bf_lo(unsigned w) { return __builtin_bit_cast(float, w << 16); }
__device__ __forceinline__ float bf_hi(unsigned w) { return __builtin_bit_cast(float, w & 0xffff0000u); }
__device__ __forceinline__ float wave_sum(float v) {
#pragma unroll
    for (int o = 1; o < 64; o <<= 1) v += __shfl_xor(v, o);
    return v;
}
__device__ __forceinline__ float dot2bf(unsigned w, unsigned x, float acc) { return __builtin_amdgcn_fdot2_f32_bf16(__builtin_bit_cast(bf16x2_t, w), __builtin_bit_cast(bf16x2_t, x), acc, false); }

__device__ __forceinline__ void phase_mod(const float* c, const float* w_ada, const float* b_ada, float* mod, unsigned char* lds, int tid, int lane, int wave) {
    float* sc = (float*)lds;
    float* red = (float*)(lds + 32768);
    bool did = false;
    for (int item = blockIdx.x; item < MODS / 64; item += gridDim.x) {
        if (!did) { for (int i = tid; i < NB * DM; i += 512) { const float v = c[i]; sc[i] = v / (1.f + __expf(-v)); } __syncthreads(); did = true; }
        const int e0 = item * 64, cg = lane & 15, rs = lane >> 4;
        float acc[8][4];
#pragma unroll
        for (int b = 0; b < 8; ++b) { acc[b][0] = 0.f; acc[b][1] = 0.f; acc[b][2] = 0.f; acc[b][3] = 0.f; }
#pragma unroll 4
        for (int it = 0; it < 32; ++it) {
            const int d = wave * 128 + it * 4 + rs;
            const f32x4 wv = *(const f32x4*)(w_ada + (size_t)d * MODS + e0 + 4 * cg);
#pragma unroll
            for (int b = 0; b < 8; ++b) { const float s = sc[b * DM + d]; acc[b][0] += s * wv[0]; acc[b][1] += s * wv[1]; acc[b][2] += s * wv[2]; acc[b][3] += s * wv[3]; }
        }
#pragma unroll
        for (int b = 0; b < 8; ++b)
#pragma unroll
            for (int j = 0; j < 4; ++j) { float v = acc[b][j]; v += __shfl_xor(v, 16); v += __shfl_xor(v, 32); if (rs == 0) red[(wave * 8 + b) * 64 + 4 * cg + j] = v; }
        __syncthreads();
        { const int b = tid >> 6, col = tid & 63; float s = b_ada[e0 + col];
#pragma unroll
          for (int w = 0; w < 8; ++w) s += red[(w * 8 + b) * 64 + col];
          mod[b * MODS + e0 + col] = s; }
        __syncthreads();
    }
}

__device__ __forceinline__ void transpose_item(const float* W, int ldw, int col0, int K, bf16* WT, int row_off, float scale, LAS float* scr, int kb, int nb, int lane) {
    const int k0 = 64 * kb, n0 = 32 * nb;
#pragma unroll 8
    for (int i = 0; i < 32; ++i) { const int kk = 2 * i + (lane >> 5); scr[kk * 33 + (lane & 31)] = W[(size_t)(k0 + kk) * ldw + col0 + n0 + (lane & 31)]; }
    LDS_WAIT(); asm volatile("" ::: "memory");
    const int c = lane & 7;
#pragma unroll
    for (int j = 0; j < 4; ++j) { const int n = (lane >> 3) + 8 * j; const LAS float* s = scr + (8 * c) * 33 + n;
        v4u o; o.x = cvtpk(s[0 * 33] * scale, s[1 * 33] * scale); o.y = cvtpk(s[2 * 33] * scale, s[3 * 33] * scale); o.z = cvtpk(s[4 * 33] * scale, s[5 * 33] * scale); o.w = cvtpk(s[6 * 33] * scale, s[7 * 33] * scale);
        *(v4u*)(WT + (size_t)(row_off + n0 + n) * K + k0 + 8 * c) = o; }
    LDS_WAIT(); asm volatile("" ::: "memory");
}
__device__ __forceinline__ bf16x8 ld8_f32_bf16(const float* p) {
    const f32x4 a = *(const f32x4*)p, b = *(const f32x4*)(p + 4);
    v4u o; o.x = cvtpk(a[0], a[1]); o.y = cvtpk(a[2], a[3]); o.z = cvtpk(b[0], b[1]); o.w = cvtpk(b[2], b[3]);
    return __builtin_bit_cast(bf16x8, o);
}
__device__ __forceinline__ void wc_item(const float* w_query, const float* sub_keys, bf16* WcT, int item, int lane) {
    const int hp = item >> 6, d0 = (item & 63) * 16, p = hp & 1;
    const int r = lane & 15, kg = lane >> 4;
    bf16x8 a[4];
#pragma unroll
    for (int ks = 0; ks < 4; ++ks) a[ks] = ld8_f32_bf16(w_query + (size_t)(d0 + r) * 2048 + hp * 128 + ks * 32 + 8 * kg);
#pragma unroll
    for (int nt = 0; nt < 8; ++nt) {
        f32x4 acc = {0.f, 0.f, 0.f, 0.f};
#pragma unroll
        for (int ks = 0; ks < 4; ++ks) { const bf16x8 b = ld8_f32_bf16(sub_keys + (size_t)(p * 128 + nt * 16 + r) * 128 + ks * 32 + 8 * kg);
            acc = __builtin_amdgcn_mfma_f32_16x16x32_bf16(a[ks], b, acc, 0, 0, 0); }
        u32x2 o; o.x = cvtpk(acc[0], acc[1]); o.y = cvtpk(acc[2], acc[3]);
        *(u32x2*)(WcT + (size_t)(hp * 128 + nt * 16 + r) * DM + d0 + 4 * kg) = o;
    }
}
struct RowStats { float mean, rstd; };
__device__ __forceinline__ RowStats row_stats(const f32x4 (&v)[4]) {
    float s = 0.f;
#pragma unroll
    for (int j = 0; j < 4; ++j) s += (v[j][0] + v[j][1]) + (v[j][2] + v[j][3]);
    const float mean = wave_sum(s) * (1.f / DM); float s2 = 0.f;
#pragma unroll
    for (int j = 0; j < 4; ++j) { const f32x4 d = v[j] - mean; s2 += (d[0] * d[0] + d[1] * d[1]) + (d[2] * d[2] + d[3] * d[3]); }
    RowStats r; r.mean = mean; r.rstd = 1.f / sqrtf(wave_sum(s2) * (1.f / DM) + LN_EPS); return r;
}
__device__ __forceinline__ void phase_prologue(const float* const* in, unsigned char* ws, LAS unsigned char* lds, int lane, int wave) {
    const float* x = in[0]; const float* w_in = in[4]; const float* w_out = in[5]; const float* w_query = in[15]; const float* sub_keys = in[16];
    const float* mod = (const float*)(ws + WS_MOD);
    LAS float* scr = (LAS float*)(lds + wave * 16384);
    const int gw = blockIdx.x * NWAVES + wave, NGW = gridDim.x * NWAVES;
    for (int it = gw; it < 2048; it += NGW) {
        const int seg = it >> 8, r = it & 255, kb = r >> 4, nb = r & 15;
        switch (seg) {
            case 0: transpose_item(w_in, 3072, 0, DM, (bf16*)(ws + WS_WQK), 0, QSCALE, scr, kb, nb, lane); break;
            case 1: transpose_item(w_in, 3072, 512, DM, (bf16*)(ws + WS_WQK), 512, 1.f, scr, kb, nb, lane); break;
            case 2: transpose_item(w_in, 3072, 1536, DM, (bf16*)(ws + WS_WQK), 1024, QSCALE, scr, kb, nb, lane); break;
            case 3: transpose_item(w_in, 3072, 2048, DM, (bf16*)(ws + WS_WQK), 1536, 1.f, scr, kb, nb, lane); break;
            case 4: transpose_item(w_in, 3072, 1024, DM, (bf16*)(ws + WS_WV), 0, 1.f, scr, kb, nb, lane); break;
            case 5: transpose_item(w_in, 3072, 2560, DM, (bf16*)(ws + WS_WV), 512, 1.f, scr, kb, nb, lane); break;
            case 6: transpose_item(w_out, 1024, 0, DM, (bf16*)(ws + WS_WO), 0, 1.f, scr, kb, nb, lane); break;
            default: transpose_item(w_out, 1024, 512, DM, (bf16*)(ws + WS_WO), 512, 1.f, scr, kb, nb, lane); break;
        }
    }
    for (int it = gw; it < 1024; it += NGW) wc_item(w_query, sub_keys, (bf16*)(ws + WS_WC), it, lane);
    for (int m = gw; m < MTOK; m += NGW) {
        const int b = m >> 11; const float* sh = mod + b * MODS; const float* scp = sh + DM;
        const f32x4* xr = (const f32x4*)(x + (size_t)m * DM) + lane;
        f32x4 v[4];
#pragma unroll
        for (int j = 0; j < 4; ++j) v[j] = xr[64 * j];
        const RowStats st = row_stats(v);
        u32x2* o8 = (u32x2*)((bf16*)(ws + WS_XN) + (size_t)m * DM) + lane;
#pragma unroll
        for (int j = 0; j < 4; ++j) { const f32x4 s4 = *((const f32x4*)scp + lane + 64 * j), h4 = *((const f32x4*)sh + lane + 64 * j);
            const f32x4 y = (v[j] - st.mean) * st.rstd * (s4 + 1.0f) + h4; u32x2 o; o.x = cvtpk(y[0], y[1]); o.y = cvtpk(y[2], y[3]); o8[64 * j] = o; }
    }
    for (int rr = gw; rr < 32768; rr += NGW) {
        const bool up = rr >= 16384; const int e = up ? rr - 16384 : rr;
        const float* src = (up ? in[18] : in[17]) + (size_t)e * DM + 16 * lane;
        f32x4 v[4]; float am = 0.f;
#pragma unroll
        for (int j = 0; j < 4; ++j) { v[j] = *(const f32x4*)(src + 4 * j); am = fmaxf(am, fmaxf(fmaxf(fabsf(v[j][0]), fabsf(v[j][1])), fmaxf(fabsf(v[j][2]), fabsf(v[j][3])))); }
#pragma unroll
        for (int o = 1; o < 64; o <<= 1) am = fmaxf(am, __shfl_xor(am, o));
        const float sc = am > 0.f ? 384.f / am : 1.f;
        v4u q;
        { int w = 0; w = __builtin_amdgcn_cvt_pk_fp8_f32(v[0][0] * sc, v[0][1] * sc, w, false); w = __builtin_amdgcn_cvt_pk_fp8_f32(v[0][2] * sc, v[0][3] * sc, w, true); q.x = (unsigned)w; }
        { int w = 0; w = __builtin_amdgcn_cvt_pk_fp8_f32(v[1][0] * sc, v[1][1] * sc, w, false); w = __builtin_amdgcn_cvt_pk_fp8_f32(v[1][2] * sc, v[1][3] * sc, w, true); q.y = (unsigned)w; }
        { int w = 0; w = __builtin_amdgcn_cvt_pk_fp8_f32(v[2][0] * sc, v[2][1] * sc, w, false); w = __builtin_amdgcn_cvt_pk_fp8_f32(v[2][2] * sc, v[2][3] * sc, w, true); q.z = (unsigned)w; }
        { int w = 0; w = __builtin_amdgcn_cvt_pk_fp8_f32(v[3][0] * sc, v[3][1] * sc, w, false); w = __builtin_amdgcn_cvt_pk_fp8_f32(v[3][2] * sc, v[3][3] * sc, w, true); q.w = (unsigned)w; }
        if (!up) { *(v4u*)(ws + WS_TDN + ((size_t)(lane >> 3) * 16384 + e) * 128 + 16 * (lane & 7)) = q; if (lane == 0) ((float*)(ws + WS_SDN))[e] = am > 0.f ? am * (1.f / 384.f) : 1.f; }
        else { *(v4u*)(ws + WS_TUP + ((size_t)(lane >> 3) * 16384 + e) * 128 + 16 * (lane & 7)) = q; if (lane == 0) ((float*)(ws + WS_SUP))[e] = am > 0.f ? am * (1.f / 384.f) : 1.f; }
    }
}

constexpr int ATT_KSTR = 144, ATT_VSTR = 136;
constexpr int ATT_K0 = 0, ATT_K1 = 64 * ATT_KSTR, ATT_V = 2 * 64 * ATT_KSTR, ATT_BUF = ATT_V + 128 * ATT_VSTR;
constexpr int ATT_TAB = 98304;
constexpr int ATT_RPB_N = 8 * 15 * 31, ATT_T5_N = 4 * 257;
static_assert(2 * ATT_BUF <= 65536 + 8192 && ATT_TAB + (ATT_RPB_N + ATT_T5_N + 4) * 4 <= RING_BYTES, "attention LDS map");

__device__ __forceinline__ int t5_bucket(int rel) {
    const int n = rel < 0 ? -rel : rel; int bucket = rel > 0 ? 16 : 0;
    const float nf = (float)(n < 1 ? 1 : n);
    int large = 8 + (int)(logf(nf / 8.0f) / 2.772588722239781f * 8.0f);
    large = large < 15 ? large : 15;
    return bucket + (n < 8 ? n : large);
}
__device__ __forceinline__ void att_tables(const float* na_rpb, const float* t5_bias, const float* lq1, const float* lk1, const float* lq2, const float* lk2, unsigned char* lds, int tid, int lane, int wave) {
    float* rpbL = (float*)(lds + ATT_TAB); float* t5L = rpbL + ATT_RPB_N; float* lamL = t5L + ATT_T5_N;
    for (int i = tid; i < ATT_RPB_N; i += 512) rpbL[i] = na_rpb[i] * LOG2E;
    for (int i = tid; i < ATT_T5_N; i += 512) { const int h = i / 257, rel = i % 257 - 128; t5L[i] = t5_bias[t5_bucket(rel) * 4 + h] * LOG2E; }
    if (wave == 0) { const float a = wave_sum(lq1[lane] * lk1[lane]), b = wave_sum(lq2[lane] * lk2[lane]); if (lane == 0) lamL[0] = expf(a) - expf(b) + LAMBDA_INIT; }
    __syncthreads();
}

__device__ __forceinline__ void na_item(int item, const bf16* QK, const bf16* VT, bf16* CC, const float* rpbL, int lane) {
    const int g = item & 3, r = (item >> 2) & 31, h = (item >> 7) & 7, b = item >> 10;
    const int qi = lane & 15, kg = lane >> 4;
    const int rs = min(max(r - 4, 0), 24);
    const int c0 = (g == 0) ? 0 : (g == 1) ? 8 : (g == 2) ? 24 : 32;
    const int qcol = 16 * g + qi, cs = min(max(qcol - 8, 0), 48);
    const size_t tokb = (size_t)b * SEQ;
    const bf16* qp = QK + (tokb + r * 64 + qcol) * 2048 + h * 64 + 8 * kg;
    const bf16x8 qf0 = *(const bf16x8*)qp, qf1 = *(const bf16x8*)(qp + 32);
    f32x4 s[16];
#pragma unroll
    for (int t = 0; t < 16; ++t) {
        const int i = t >> 1, half = t & 1;
        const bf16* kp = QK + (tokb + (rs + i) * 64 + c0 + 16 * half + qi) * 2048 + 512 + h * 64 + 8 * kg;
        const bf16x8 k0 = *(const bf16x8*)kp, k1 = *(const bf16x8*)(kp + 32);
        f32x4 a = {0.f, 0.f, 0.f, 0.f};
        a = __builtin_amdgcn_mfma_f32_16x16x32_bf16(k0, qf0, a, 0, 0, 0);
        a = __builtin_amdgcn_mfma_f32_16x16x32_bf16(k1, qf1, a, 0, 0, 0);
        s[t] = a;
    }
    float mx = -INFINITY;
#pragma unroll
    for (int t = 0; t < 16; ++t) {
        const int i = t >> 1, half = t & 1; const float* bp = rpbL + (h * 15 + (rs + i - r + 7)) * 31 + 15;
#pragma unroll
        for (int e = 0; e < 4; ++e) { const int kcol = c0 + 16 * half + 4 * kg + e; const bool valid = (kcol >= cs) && (kcol < cs + 16);
            const int co = min(max(kcol - qcol, -15), 15);
            const float v = valid ? s[t][e] + bp[co] : -INFINITY; s[t][e] = v; mx = fmaxf(mx, v); }
    }
    mx = fmaxf(mx, __shfl_xor(mx, 16)); mx = fmaxf(mx, __shfl_xor(mx, 32));
    float l = 0.f;
#pragma unroll
    for (int t = 0; t < 16; ++t)
#pragma unroll
        for (int e = 0; e < 4; ++e) { const float p = __builtin_amdgcn_exp2f(s[t][e] - mx); s[t][e] = p; l += p; }
    l += __shfl_xor(l, 16); l += __shfl_xor(l, 32);
    f32x4 o[4];
#pragma unroll
    for (int nt = 0; nt < 4; ++nt) o[nt] = (f32x4){0.f, 0.f, 0.f, 0.f};
#pragma unroll
    for (int kk = 0; kk < 8; ++kk) {
        v4u pw; pw.x = cvtpk(s[2 * kk][0], s[2 * kk][1]); pw.y = cvtpk(s[2 * kk][2], s[2 * kk][3]); pw.z = cvtpk(s[2 * kk + 1][0], s[2 * kk + 1][1]); pw.w = cvtpk(s[2 * kk + 1][2], s[2 * kk + 1][3]);
        const bf16x8 pb = __builtin_bit_cast(bf16x8, pw);
#pragma unroll
        for (int nt = 0; nt < 4; ++nt) {
            const bf16* vp = VT + (size_t)(h * 64 + nt * 16 + qi) * MTOK + tokb + (rs + kk) * 64 + c0 + 4 * kg;
            const u32x2 lo = *(const u32x2*)vp, hi = *(const u32x2*)(vp + 16);
            v4u aw; aw.x = lo.x; aw.y = lo.y; aw.z = hi.x; aw.w = hi.y;
            o[nt] = __builtin_amdgcn_mfma_f32_16x16x32_bf16(__builtin_bit_cast(bf16x8, aw), pb, o[nt], 0, 0, 0);
        }
    }
    const float inv = 1.f / l;
    bf16* op = CC + (tokb + r * 64 + qcol) * DM + h * 64 + 4 * kg;
#pragma unroll
    for (int nt = 0; nt < 4; ++nt) { u32x2 w; w.x = cvtpk(o[nt][0] * inv, o[nt][1] * inv); w.y = cvtpk(o[nt][2] * inv, o[nt][3] * inv); *(u32x2*)(op + nt * 16) = w; }
}

__device__ __forceinline__ int crow(int r, int hi) { return (r & 3) + 8 * (r >> 2) + 4 * hi; }

__device__ __forceinline__ void diff_unit(int unit, const bf16* QK, const bf16* VT, bf16* CC, const float* subln, unsigned char* lds, int tid, int lane, int wave) {
    const int qb = unit & 15, h = (unit >> 4) & 3, b = unit >> 6;
    const int mp = wave >> 2, qs = wave & 3, r32 = lane & 31, hi = lane >> 5;
    const size_t tokb = (size_t)b * SEQ;
    const int q0 = qb * 128 + qs * 32;
    const float* t5L = (const float*)(lds + ATT_TAB) + ATT_RPB_N + h * 257 + 128;
    const float lam = ((const float*)(lds + ATT_TAB))[ATT_RPB_N + ATT_T5_N];
    const float cL = t5L[-128], cR = t5L[128];
    bf16x8 qf[4];
    { const bf16* qp = QK + (tokb + q0 + r32) * 2048 + 1024 + h * 128 + mp * 64 + 8 * hi;
#pragma unroll
      for (int d0 = 0; d0 < 4; ++d0) qf[d0] = *(const bf16x8*)(qp + d0 * 16); }
    const bf16* ksrc = QK + (tokb + (tid >> 3)) * 2048 + 1536 + h * 128 + (tid & 7) * 8;
    const bf16* vsrc = VT + (size_t)(512 + h * 128 + (tid >> 3)) * MTOK + tokb + (tid & 7) * 8;
    const int kdst = (tid >> 3) * ATT_KSTR + (tid & 7) * 16, vdst = ATT_V + (tid >> 3) * ATT_VSTR + (tid & 7) * 16;
    v4u sk[2], sv[2];
#define DIFF_LOAD(t) do { sk[0] = *(const v4u*)(ksrc + (size_t)(t) * 64 * 2048); sk[1] = *(const v4u*)(ksrc + (size_t)(t) * 64 * 2048 + 64); \
        sv[0] = *(const v4u*)(vsrc + (t) * 64); sv[1] = *(const v4u*)(vsrc + (size_t)64 * MTOK + (t) * 64); } while (0)
#define DIFF_STORE(buf) do { unsigned char* bb_ = lds + (buf) * ATT_BUF; *(v4u*)(bb_ + ATT_K0 + kdst) = sk[0]; *(v4u*)(bb_ + ATT_K1 + kdst) = sk[1]; \
        *(u32x2*)(bb_ + vdst) = (u32x2){sv[0].x, sv[0].y}; *(u32x2*)(bb_ + vdst + 8) = (u32x2){sv[0].z, sv[0].w}; \
        *(u32x2*)(bb_ + vdst + 64 * ATT_VSTR) = (u32x2){sv[1].x, sv[1].y}; *(u32x2*)(bb_ + vdst + 64 * ATT_VSTR + 8) = (u32x2){sv[1].z, sv[1].w}; } while (0)
    DIFF_LOAD(0); DIFF_STORE(0); __syncthreads();
    f32x16 o[4];
#pragma unroll
    for (int k = 0; k < 4; ++k)
#pragma unroll
        for (int e = 0; e < 16; ++e) o[k][e] = 0.f;
    float m_run = -1e30f, l_run = 0.f;
    const int qpos = q0 + r32;
    for (int t = 0; t < SEQ / 64; ++t) {
        if (t + 1 < SEQ / 64) DIFF_LOAD(t + 1);
        const unsigned char* bb = lds + (t & 1) * ATT_BUF;
        const unsigned char* kb_ = bb + (mp ? ATT_K1 : ATT_K0) + r32 * ATT_KSTR + hi * 16;
        const bool farL = (64 * t + 63 - q0) <= -91, farR = (64 * t - (q0 + 31)) >= 91;
        const float cinit = farL ? cL : (farR ? cR : 0.f);
        f32x16 p0, p1;
#pragma unroll
        for (int e = 0; e < 16; ++e) { p0[e] = cinit; p1[e] = cinit; }
#pragma unroll
        for (int d0 = 0; d0 < 4; ++d0) {
            const bf16x8 ka = *(const bf16x8*)(kb_ + d0 * 32), kc = *(const bf16x8*)(kb_ + 32 * ATT_KSTR + d0 * 32);
            p0 = __builtin_amdgcn_mfma_f32_32x32x16_bf16(ka, qf[d0], p0, 0, 0, 0);
            p1 = __builtin_amdgcn_mfma_f32_32x32x16_bf16(kc, qf[d0], p1, 0, 0, 0);
        }
        if (!(farL || farR)) {
            const int rel0 = 64 * t - qpos;
#pragma unroll
            for (int e = 0; e < 16; ++e) { const int ra = rel0 + crow(e, hi); const int rb = ra + 32;
                p0[e] += t5L[min(max(ra, -128), 128)]; p1[e] += t5L[min(max(rb, -128), 128)]; }
        }
        float mx = p0[0];
#pragma unroll
        for (int e = 1; e < 16; ++e) mx = fmaxf(mx, p0[e]);
#pragma unroll
        for (int e = 0; e < 16; ++e) mx = fmaxf(mx, p1[e]);
        mx = fmaxf(mx, __shfl_xor(mx, 32));
        const float m_new = fmaxf(m_run, mx), alpha = __builtin_amdgcn_exp2f(m_run - m_new);
        m_run = m_new;
        float ls = 0.f;
#pragma unroll
        for (int e = 0; e < 16; ++e) { p0[e] = __builtin_amdgcn_exp2f(p0[e] - m_new); p1[e] = __builtin_amdgcn_exp2f(p1[e] - m_new); ls += p0[e] + p1[e]; }
        l_run = l_run * alpha + ls;
#pragma unroll
        for (int k = 0; k < 4; ++k)
#pragma unroll
            for (int e = 0; e < 16; ++e) o[k][e] *= alpha;
        bf16x8 pf[4];
        { v4u w;
          w.x = cvtpk(p0[0], p0[1]); w.y = cvtpk(p0[2], p0[3]); w.z = cvtpk(p0[4], p0[5]); w.w = cvtpk(p0[6], p0[7]); pf[0] = __builtin_bit_cast(bf16x8, w);
          w.x = cvtpk(p0[8], p0[9]); w.y = cvtpk(p0[10], p0[11]); w.z = cvtpk(p0[12], p0[13]); w.w = cvtpk(p0[14], p0[15]); pf[1] = __builtin_bit_cast(bf16x8, w);
          w.x = cvtpk(p1[0], p1[1]); w.y = cvtpk(p1[2], p1[3]); w.z = cvtpk(p1[4], p1[5]); w.w = cvtpk(p1[6], p1[7]); pf[2] = __builtin_bit_cast(bf16x8, w);
          w.x = cvtpk(p1[8], p1[9]); w.y = cvtpk(p1[10], p1[11]); w.z = cvtpk(p1[12], p1[13]); w.w = cvtpk(p1[14], p1[15]); pf[3] = __builtin_bit_cast(bf16x8, w); }
        const unsigned char* vb_ = bb + ATT_V + r32 * ATT_VSTR + hi * 8;
#pragma unroll
        for (int blk = 0; blk < 4; ++blk)
#pragma unroll
            for (int ks = 0; ks < 4; ++ks) {
                const unsigned char* vp = vb_ + blk * 32 * ATT_VSTR + ks * 32;
                const u32x2 lo = *(const u32x2*)vp, hv = *(const u32x2*)(vp + 16);
                v4u aw; aw.x = lo.x; aw.y = lo.y; aw.z = hv.x; aw.w = hv.y;
                o[blk] = __builtin_amdgcn_mfma_f32_32x32x16_bf16(__builtin_bit_cast(bf16x8, aw), pf[ks], o[blk], 0, 0, 0);
            }
        if (t + 1 < SEQ / 64) DIFF_STORE((t + 1) & 1);
        __syncthreads();
    }
#undef DIFF_LOAD
#undef DIFF_STORE
    const float ltot = l_run + __shfl_xor(l_run, 32);
    const float inv = (mp ? lam : 1.f) / ltot;
    float* exch = (float*)lds + qs * 4096;
    if (mp == 1) {
#pragma unroll
        for (int k = 0; k < 4; ++k)
#pragma unroll
            for (int e = 0; e < 16; ++e) exch[(k * 16 + e) * 64 + lane] = o[k][e] * inv;
    }
    __syncthreads();
    if (mp == 0) {
        float ss = 0.f;
#pragma unroll
        for (int k = 0; k < 4; ++k)
#pragma unroll
            for (int e = 0; e < 16; ++e) { const float d = o[k][e] * inv - exch[(k * 16 + e) * 64 + lane]; o[k][e] = d; ss += d * d; }
        ss += __shfl_xor(ss, 32);
        const float rn = (1.0f - LAMBDA_INIT) / sqrtf(ss * (1.f / 128.f) + LN_EPS);
        bf16* op = CC + (tokb + q0 + r32) * DM + 512 + h * 128 + 4 * hi;
#pragma unroll
        for (int k = 0; k < 4; ++k)
#pragma unroll
            for (int g4 = 0; g4 < 4; ++g4) { const int dv = k * 32 + 8 * g4 + 4 * hi; const f32x4 sg = *(const f32x4*)(subln + dv);
                u32x2 w; w.x = cvtpk(o[k][4 * g4] * rn * sg[0], o[k][4 * g4 + 1] * rn * sg[1]); w.y = cvtpk(o[k][4 * g4 + 2] * rn * sg[2], o[k][4 * g4 + 3] * rn * sg[3]);
                *(u32x2*)(op + k * 32 + 8 * g4) = w; }
    }
    __syncthreads();
}

__device__ __forceinline__ void phase_attention(const float* const* in, unsigned char* ws, unsigned char* lds, int tid, int lane, int wave) {
    const bf16* QK = (const bf16*)(ws + WS_QK); const bf16* VT = (const bf16*)(ws + WS_VT); bf16* CC = (bf16*)(ws + WS_CC);
    att_tables(in[6], in[7], in[8], in[9], in[10], in[11], lds, tid, lane, wave);
    for (int u = blockIdx.x; u < 512; u += gridDim.x) diff_unit(u, QK, VT, CC, in[12], lds, tid, lane, wave);
    const float* rpbL = (const float*)(lds + ATT_TAB);
    const int gw = blockIdx.x * NWAVES + wave, NGW = gridDim.x * NWAVES;
    for (int it = gw; it < 8192; it += NGW) na_item(it, QK, VT, CC, rpbL, lane);
}

__device__ __forceinline__ void phase_rows(const float* const* in, unsigned char* ws, float* X1, int lane, int wave) {
    const float* Y = (const float*)(ws + WS_Y); const float* mod = (const float*)(ws + WS_MOD); bf16* H2 = (bf16*)(ws + WS_H2);
    const float* g1 = in[13]; const float* b1 = in[14];
    const int gw = blockIdx.x * NWAVES + wave, NGW = gridDim.x * NWAVES;
    for (int m = gw; m < MTOK; m += NGW) {
        const int b = m >> 11; const float* sh = mod + b * MODS + 3 * DM; const float* scp = mod + b * MODS + 4 * DM;
        const f32x4* yr = (const f32x4*)(Y + (size_t)m * DM) + lane;
        f32x4 v[4];
#pragma unroll
        for (int j = 0; j < 4; ++j) v[j] = yr[64 * j];
        const RowStats s1 = row_stats(v);
        f32x4* xo = (f32x4*)(X1 + (size_t)m * DM) + lane;
#pragma unroll
        for (int j = 0; j < 4; ++j) { const f32x4 gg = *((const f32x4*)g1 + lane + 64 * j), bb = *((const f32x4*)b1 + lane + 64 * j);
            v[j] = (v[j] - s1.mean) * s1.rstd * gg + bb; xo[64 * j] = v[j]; }
        const RowStats s2 = row_stats(v);
        u32x2* o8 = (u32x2*)(H2 + (size_t)m * DM) + lane;
#pragma unroll
        for (int j = 0; j < 4; ++j) { const f32x4 s4 = *((const f32x4*)scp + lane + 64 * j), h4 = *((const f32x4*)sh + lane + 64 * j);
            const f32x4 y = (v[j] - s2.mean) * s2.rstd * (s4 + 1.0f) + h4; u32x2 o; o.x = cvtpk(y[0], y[1]); o.y = cvtpk(y[2], y[3]); o8[64 * j] = o; }
    }
}

__device__ __forceinline__ unsigned key_enc(float v, int n) { const unsigned u = __builtin_bit_cast(unsigned, v); const unsigned k = u ^ (((int)u >> 31) | 0x80000000u); return (k & ~127u) | (unsigned)(127 - n); }
__device__ __forceinline__ float key_val(unsigned k) { k &= ~127u; const unsigned u = (k & 0x80000000u) ? (k ^ 0x80000000u) : ~k; return __builtin_bit_cast(float, u); }
__device__ __forceinline__ int key_idx(unsigned k) { return 127 - (int)(k & 127u); }
__device__ __forceinline__ float gelu_erf(float x) { return 0.5f * x * (1.f + erff(x * 0.70710678118654752f)); }

constexpr int PE_TOK = 64;
constexpr int PE_ID = 0, PE_G = 32768;
__device__ __forceinline__ void phase_topk(unsigned char* ws, unsigned char* lds, int tid, int lane, int wave) {
    const float* ST = (const float*)(ws + WS_ST); f32x2v* IDG = (f32x2v*)(ws + WS_IDG);
    int* idL = (int*)(lds + PE_ID); float* gL = (float*)(lds + PE_G);
    for (int tile = blockIdx.x; tile < MTOK / PE_TOK; tile += gridDim.x) {
        const int tok0 = tile * PE_TOK;
        {
            unsigned tk[2][16];
#pragma unroll
            for (int p = 0; p < 2; ++p) {
#pragma unroll
                for (int i = 0; i < 16; ++i) tk[p][i] = 0u;
                const float* sp = ST + (size_t)(wave * 256 + p * 128) * MTOK + tok0 + lane;
#pragma unroll 8
                for (int n = 0; n < 128; ++n) {
                    unsigned v = key_enc(sp[(size_t)n * MTOK], n);
#pragma unroll
                    for (int i = 0; i < 16; ++i) { const unsigned hi_ = max(tk[p][i], v); v = min(tk[p][i], v); tk[p][i] = hi_; }
                }
            }
            float bv[16]; int bi[16];
#pragma unroll
            for (int i = 0; i < 16; ++i) { bv[i] = -INFINITY; bi[i] = 0; }
#pragma unroll
            for (int i = 0; i < 16; ++i)
#pragma unroll
                for (int j = 0; j < 16; ++j) if ((i + 1) * (j + 1) <= 16) {
                    float v = key_val(tk[0][i]) + key_val(tk[1][j]); int id = key_idx(tk[0][i]) * 128 + key_idx(tk[1][j]);
#pragma unroll
                    for (int k = 0; k < 16; ++k) { const bool c = v > bv[k]; const float nv = c ? bv[k] : v; const int ni = c ? bi[k] : id; bv[k] = c ? v : bv[k]; bi[k] = c ? id : bi[k]; v = nv; id = ni; }
                }
            float sum = 0.f; const float bmax = bv[0];
#pragma unroll
            for (int k = 0; k < 16; ++k) { bv[k] = __expf(bv[k] - bmax); sum += bv[k]; }
            const float rinv = 1.f / sum;
#pragma unroll
            for (int k = 0; k < 16; ++k) { idL[(wave * 16 + k) * 64 + lane] = bi[k]; gL[(wave * 16 + k) * 64 + lane] = bv[k] * rinv; }
        }
        __syncthreads();
#pragma unroll
        for (int i = 0; i < 8; ++i) { const int tl = wave * 8 + i;
#pragma unroll
            for (int hf = 0; hf < 2; ++hf) { const int e = lane + 64 * hf; f32x2v pr; pr.x = __builtin_bit_cast(float, idL[e * 64 + tl]); pr.y = gL[e * 64 + tl]; IDG[(size_t)(tok0 + tl) * 128 + e] = pr; } }
        __syncthreads();
    }
}

__device__ __forceinline__ float wave_sum_u(float v) {
    v += __builtin_bit_cast(float, __builtin_amdgcn_update_dpp(0, __builtin_bit_cast(int, v), 0xB1, 0xf, 0xf, false));
    v += __builtin_bit_cast(float, __builtin_amdgcn_update_dpp(0, __builtin_bit_cast(int, v), 0x4E, 0xf, 0xf, false));
    v += __builtin_bit_cast(float, __builtin_amdgcn_update_dpp(0, __builtin_bit_cast(int, v), 0x141, 0xf, 0xf, false));
    v += __builtin_bit_cast(float, __builtin_amdgcn_update_dpp(0, __builtin_bit_cast(int, v), 0x140, 0xf, 0xf, false));
    v += __builtin_bit_cast(float, __builtin_amdgcn_update_dpp(0, __builtin_bit_cast(int, v), 0x142, 0xa, 0xf, false));
    v += __builtin_bit_cast(float, __builtin_amdgcn_update_dpp(0, __builtin_bit_cast(int, v), 0x143, 0xc, 0xf, false));
    return __builtin_bit_cast(float, __builtin_amdgcn_readlane(__builtin_bit_cast(int, v), 63));
}
struct SliceMap { int n_x, rank; unsigned own; };
__device__ __forceinline__ SliceMap slice_setup(unsigned* bar, unsigned x, volatile LAS unsigned* st, int tid, bool census) {
    if (census) {
        if (tid == 0) {
            unsigned np = 0, mi = 0, mine = 1;
#pragma unroll
            for (unsigned j = 0; j < 16; ++j) { const unsigned c = xb_ld(&bar[XB_XCNT(j)]); if (c > 0u) { if (j == x) { mi = np; mine = c; } ++np; } }
            if (np == 0u) np = 1u;
            unsigned mask = 0u;
#pragma unroll
            for (unsigned sl = 0; sl < 8; ++sl) if (sl % np == mi) mask |= 1u << sl;
            st[3] = mine; st[4] = mask;
        }
        __syncthreads();
        SliceMap m; m.n_x = (int)st[3]; m.rank = (int)st[2]; m.own = st[4]; return m;
    } else { SliceMap m; m.n_x = gridDim.x / 8; m.rank = blockIdx.x >> 3; m.own = 1u << (blockIdx.x & 7); return m; }
}
__device__ __forceinline__ f32x2v fp8x2(unsigned w, bool hi) { return hi ? __builtin_amdgcn_cvt_pk_f32_fp8((int)w, true) : __builtin_amdgcn_cvt_pk_f32_fp8((int)w, false); }

__device__ __forceinline__ float sum8_dpp(float v) {
    v += __builtin_bit_cast(float, __builtin_amdgcn_update_dpp(0, __builtin_bit_cast(int, v), 0xB1, 0xf, 0xf, false));
    v += __builtin_bit_cast(float, __builtin_amdgcn_update_dpp(0, __builtin_bit_cast(int, v), 0x4E, 0xf, 0xf, false));
    v += __builtin_bit_cast(float, __builtin_amdgcn_update_dpp(0, __builtin_bit_cast(int, v), 0x141, 0xf, 0xf, false));
    return v;
}
__device__ __forceinline__ void phase_down(unsigned char* ws, const SliceMap sm, int lane, int wave) {
    const unsigned* IDX = (const unsigned*)(ws + WS_IDG); const unsigned char* TDN = ws + WS_TDN; const bf16* H2 = (const bf16*)(ws + WS_H2); float* P = (float*)(ws + WS_P);
    const int gwx = sm.rank * NWAVES + wave, nwx = sm.n_x * NWAVES;
    const int eg = lane >> 3, cs = lane & 7;
    for (int s = 0; s < 8; ++s) {
        if (!((sm.own >> s) & 1u)) continue;
        const unsigned char* tb = TDN + (size_t)s * 16384 * 128 + 16 * cs;
        for (int t = gwx; t < MTOK; t += nwx) {
            unsigned id[16];
#pragma unroll
            for (int i = 0; i < 16; ++i) id[i] = IDX[((size_t)t * 128 + 8 * i + eg) * 2];
            f32x2v hx[8];
            { const v4u* hp = (const v4u*)(H2 + (size_t)t * DM + 128 * s + 16 * cs); const v4u h0 = hp[0], h1 = hp[1];
              hx[0] = (f32x2v){bf_lo(h0.x), bf_hi(h0.x)}; hx[1] = (f32x2v){bf_lo(h0.y), bf_hi(h0.y)}; hx[2] = (f32x2v){bf_lo(h0.z), bf_hi(h0.z)}; hx[3] = (f32x2v){bf_lo(h0.w), bf_hi(h0.w)};
              hx[4] = (f32x2v){bf_lo(h1.x), bf_hi(h1.x)}; hx[5] = (f32x2v){bf_lo(h1.y), bf_hi(h1.y)}; hx[6] = (f32x2v){bf_lo(h1.z), bf_hi(h1.z)}; hx[7] = (f32x2v){bf_lo(h1.w), bf_hi(h1.w)}; }
            v4u q[16];
#pragma unroll
            for (int i = 0; i < 16; ++i) q[i] = *(const v4u*)(tb + (size_t)id[i] * 128);
            float r0 = 0.f, r1 = 0.f;
#pragma unroll
            for (int i = 0; i < 16; ++i) {
                f32x2v a = fp8x2(q[i].x, false) * hx[0], b2 = fp8x2(q[i].x, true) * hx[1];
                a += fp8x2(q[i].y, false) * hx[2]; b2 += fp8x2(q[i].y, true) * hx[3];
                a += fp8x2(q[i].z, false) * hx[4]; b2 += fp8x2(q[i].z, true) * hx[5];
                a += fp8x2(q[i].w, false) * hx[6]; b2 += fp8x2(q[i].w, true) * hx[7];
                const float tot = sum8_dpp((a[0] + a[1]) + (b2[0] + b2[1]));
                if (i < 8) r0 = (cs == i) ? tot : r0; else r1 = (cs == i - 8) ? tot : r1;
            }
            float* pp = P + ((size_t)s * MTOK + t) * 128 + 8 * cs + eg;
            pp[0] = r0; pp[64] = r1;
        }
    }
}

__device__ __forceinline__ void phase_combine(unsigned char* ws, int lane, int wave) {
    const f32x2v* IDG = (const f32x2v*)(ws + WS_IDG); f32x2v* CW = (f32x2v*)(ws + WS_CW); const float* P = (const float*)(ws + WS_P);
    const float* SDN = (const float*)(ws + WS_SDN); const float* SUP = (const float*)(ws + WS_SUP);
    const int gw = blockIdx.x * NWAVES + wave, NGW = gridDim.x * NWAVES;
    for (int t = gw; t < MTOK; t += NGW) {
#pragma unroll
        for (int hf = 0; hf < 2; ++hf) {
            const int e = lane + 64 * hf;
            const f32x2v pr = IDG[(size_t)t * 128 + e]; const unsigned id = __builtin_bit_cast(unsigned, pr.x);
            float sum = 0.f;
#pragma unroll
            for (int x = 0; x < 8; ++x) sum += P[((size_t)x * MTOK + t) * 128 + e];
            const float c = pr.y * gelu_erf(sum * SDN[id]) * SUP[id];
            f32x2v o; o.x = pr.x; o.y = c; CW[(size_t)t * 128 + e] = o;
        }
    }
}

__device__ __forceinline__ void phase_up(unsigned char* ws, const SliceMap sm, int lane, int wave) {
    const f32x2v* CW = (const f32x2v*)(ws + WS_CW); const unsigned char* TUP = ws + WS_TUP; float* F = (float*)(ws + WS_F);
    const int gwx = sm.rank * NWAVES + wave, nwx = sm.n_x * NWAVES;
    const int eg = lane >> 3, cs = lane & 7;
    for (int s = 0; s < 8; ++s) {
        if (!((sm.own >> s) & 1u)) continue;
        const unsigned char* tb = TUP + (size_t)s * 16384 * 128 + 16 * cs;
        for (int t = gwx; t < MTOK; t += nwx) {
            f32x2v pr[16];
#pragma unroll
            for (int i = 0; i < 16; ++i) pr[i] = CW[(size_t)t * 128 + 8 * i + eg];
            v4u q[16];
#pragma unroll
            for (int i = 0; i < 16; ++i) q[i] = *(const v4u*)(tb + (size_t)__builtin_bit_cast(unsigned, pr[i].x) * 128);
            f32x2v acc[8];
#pragma unroll
            for (int k = 0; k < 8; ++k) acc[k] = (f32x2v){0.f, 0.f};
#pragma unroll
            for (int i = 0; i < 16; ++i) { const float w = pr[i].y;
                acc[0] += fp8x2(q[i].x, false) * w; acc[1] += fp8x2(q[i].x, true) * w; acc[2] += fp8x2(q[i].y, false) * w; acc[3] += fp8x2(q[i].y, true) * w;
                acc[4] += fp8x2(q[i].z, false) * w; acc[5] += fp8x2(q[i].z, true) * w; acc[6] += fp8x2(q[i].w, false) * w; acc[7] += fp8x2(q[i].w, true) * w; }
#pragma unroll
            for (int k = 0; k < 8; ++k)
#pragma unroll
                for (int c = 0; c < 2; ++c) { float v = acc[k][c]; v += __shfl_xor(v, 8); v += __shfl_xor(v, 16); v += __shfl_xor(v, 32); acc[k][c] = v; }
            if (eg == 0) { float* fp = F + (size_t)t * DM + 128 * s + 16 * cs;
#pragma unroll
                for (int k = 0; k < 4; ++k) *(f32x4*)(fp + 4 * k) = (f32x4){acc[2 * k][0], acc[2 * k][1], acc[2 * k + 1][0], acc[2 * k + 1][1]}; }
        }
    }
}

__device__ __forceinline__ void phase_final(const float* const* in, unsigned char* ws, float* OUT, int lane, int wave) {
    const float* F = (const float*)(ws + WS_F); const float* mod = (const float*)(ws + WS_MOD); const float* g2 = in[19]; const float* b2 = in[20];
    const int gw = blockIdx.x * NWAVES + wave, NGW = gridDim.x * NWAVES;
    for (int m = gw; m < MTOK; m += NGW) {
        const int b = m >> 11; const float* gf = mod + b * MODS + 5 * DM;
        f32x4* xr = (f32x4*)(OUT + (size_t)m * DM) + lane; const f32x4* fr = (const f32x4*)(F + (size_t)m * DM) + lane;
        f32x4 v[4];
#pragma unroll
        for (int j = 0; j < 4; ++j) { const f32x4 gg = *((const f32x4*)gf + lane + 64 * j); v[j] = xr[64 * j] * DN_ALPHA + (gg + 1.0f) * fr[64 * j]; }
        const RowStats st = row_stats(v);
#pragma unroll
        for (int j = 0; j < 4; ++j) { const f32x4 gg = *((const f32x4*)g2 + lane + 64 * j), bb = *((const f32x4*)b2 + lane + 64 * j); xr[64 * j] = (v[j] - st.mean) * st.rstd * gg + bb; }
    }
}

struct Args { const float* in[21]; float* out; unsigned char* ws; int ph_lo, ph_hi; };
__global__ void __launch_bounds__(NWAVES * 64, 2) fwd_kernel(Args args) {
    extern __shared__ __attribute__((aligned(16))) unsigned char lds[];
    LAS unsigned char* ldsl = (LAS unsigned char*)lds;
    const int tid = threadIdx.x, lane = tid & 63, wave = __builtin_amdgcn_readfirstlane(tid >> 6);
    const int G = gridDim.x;
    unsigned char* ws = args.ws;
    gu32* ctl = (gu32*)(ws + WS_CTL);
    for (int u = tid; u < (LDS_BYTES - LDSCTL_OFF) / 4; u += NWAVES * 64) ((LAS unsigned*)(ldsl + LDSCTL_OFF))[u] = 0u;
    __syncthreads();
    XcdBarrier bar; bar.bar = (unsigned*)(ctl + CW_BAR); bar.x = 0; bar.st = nullptr;
    volatile LAS unsigned* bst = (volatile LAS unsigned*)(ldsl + MISC_OFF) + 8;
    if (N_LAUNCHES == 1) { bar.bar = (unsigned*)(ctl + CW_BAR); bar.x = xb_xcc_id(); bar.st = bst; if (tid == 0) bst[2] = xb_add(&bar.bar[XB_XCNT(bar.x)], 1u); }
    const int lo = args.ph_lo, hi = args.ph_hi;
#define IN(k) (lo <= (k) && (k) < hi)
#define SEAM(k) do { if (IN(k) && IN((k) + 1)) xcd_barrier(bar); } while (0)

    if (IN(0)) { phase_mod(args.in[1], args.in[2], args.in[3], (float*)(ws + WS_MOD), lds, tid, lane, wave); }
    SEAM(0);
    if (IN(1)) { phase_prologue(args.in, ws, ldsl, lane, wave); }
    SEAM(1);
    if (IN(2)) {
        { pg8::Gemm g{(const bf16*)(ws + WS_XN), (const bf16*)(ws + WS_WQK), MTOK, 2048, DM}; pg8::StaticOrder S; S.init(MTOK, 2048, G, (int)blockIdx.x);
          pg8::EpiBf16 E{(bf16*)(ws + WS_QK), 2048};
          pg8::gemm_phase<pg8::EpiBf16, pg8::StaticOrder, true, true>(ldsl, g, S, E); }
        __syncthreads();
        { pg8::Gemm g{(const bf16*)(ws + WS_WV), (const bf16*)(ws + WS_XN), 1024, MTOK, DM}; pg8::StaticOrder S; S.init(1024, MTOK, G, (int)blockIdx.x);
          pg8::EpiBf16 E{(bf16*)(ws + WS_VT), MTOK};
          pg8::gemm_phase<pg8::EpiBf16, pg8::StaticOrder, true, true>(ldsl, g, S, E); }
    }
    SEAM(2);
    if (IN(3)) { __syncthreads(); phase_attention(args.in, ws, lds, tid, lane, wave); }
    SEAM(3);
    if (IN(4)) {
        pg8::Gemm g{(const bf16*)(ws + WS_CC), (const bf16*)(ws + WS_WO), MTOK, DM, DM}; pg8::StaticOrder S; S.init(MTOK, DM, G, (int)blockIdx.x);
        pg8::EpiY E{args.in[0], (const float*)(ws + WS_MOD) + 2 * DM, MODS, (float*)(ws + WS_Y), DN_ALPHA};
        pg8::gemm_phase<pg8::EpiY, pg8::StaticOrder, true, true>(ldsl, g, S, E);
    }
    SEAM(4);
    if (IN(5)) { phase_rows(args.in, ws, args.out, lane, wave); }
    SEAM(5);
    if (IN(6)) {
        pg8::Gemm g{(const bf16*)(ws + WS_WC), (const bf16*)(ws + WS_H2), 2048, MTOK, DM}; pg8::StaticOrder S; S.init(2048, MTOK, G, (int)blockIdx.x);
        pg8::EpiF32 E{(float*)(ws + WS_ST), MTOK};
        pg8::gemm_phase<pg8::EpiF32, pg8::StaticOrder, true, true>(ldsl, g, S, E);
    }
    SEAM(6);
    if (IN(7)) { __syncthreads(); phase_topk(ws, lds, tid, lane, wave); }
    SEAM(7);
    if (IN(8)) { const SliceMap sm = slice_setup((unsigned*)(ctl + CW_BAR), bar.x, bst, tid, N_LAUNCHES == 1 && lo == 0 && hi == N_PHASES); phase_down(ws, sm, lane, wave); }
    SEAM(8);
    if (IN(9)) { phase_combine(ws, lane, wave); }
    SEAM(9);
    if (IN(10)) { const SliceMap sm = slice_setup((unsigned*)(ctl + CW_BAR), bar.x, bst, tid, N_LAUNCHES == 1 && lo == 0 && hi == N_PHASES); phase_up(ws, sm, lane, wave); }
    SEAM(10);
    if (IN(11)) { phase_final(args.in, ws, args.out, lane, wave); }
#undef IN
#undef SEAM
}

extern "C" void kernel_launch(void* const* d_in, const int* in_sizes, int n_in, void* d_out, int out_size, void* d_ws, size_t ws_size, hipStream_t stream) {
    static int grid = 0;
    if (grid == 0) {
        if (n_in != 21 || out_size != MTOK * DM || ws_size < WS_END) { fprintf(stderr, "kernel_launch: unexpected shapes (n_in %d out %d ws %zu)\n", n_in, out_size, ws_size); grid = -1; return; }
        int dev = 0, cus = 0, per_cu = 0;
        if (hipGetDevice(&dev) != hipSuccess || hipDeviceGetAttribute(&cus, hipDeviceAttributeMultiprocessorCount, dev) != hipSuccess) { grid = -1; return; }
        if (hipFuncSetAttribute((const void*)fwd_kernel, hipFuncAttributeMaxDynamicSharedMemorySize, LDS_BYTES) != hipSuccess) { fprintf(stderr, "kernel_launch: hipFuncSetAttribute failed\n"); grid = -1; return; }
        if (hipOccupancyMaxActiveBlocksPerMultiprocessor(&per_cu, (const void*)fwd_kernel, NWAVES * 64, LDS_BYTES) != hipSuccess || per_cu < 1) { fprintf(stderr, "kernel_launch: occupancy query says %d\n", per_cu); }
        (void)hipGetLastError();
        grid = cus;
    }
    if (grid < 0) return;
    if (hipMemsetAsync((char*)d_ws + WS_CTL, 0, CTL_ZERO_BYTES, stream) != hipSuccess) return;
    Args a{};
    for (int i = 0; i < 21; ++i) a.in[i] = (const float*)d_in[i];
    a.out = (float*)d_out; a.ws = (unsigned char*)d_ws;
    if (N_LAUNCHES == 1) { a.ph_lo = 0; a.ph_hi = N_PHASES; hipLaunchKernelGGL(fwd_kernel, dim3(grid), dim3(NWAVES * 64), LDS_BYTES, stream, a); }
    else { for (int p = 0; p < N_PHASES; ++p) { a.ph_lo = p; a.ph_hi = p + 1; hipLaunchKernelGGL(fwd_kernel, dim3(grid), dim3(NWAVES * 64), LDS_BYTES, stream, a); } }
    if (PROBE_EXTRA_MASK) { for (int p = 0; p < N_PHASES; ++p) if ((PROBE_EXTRA_MASK >> p) & 1) { a.ph_lo = p; a.ph_hi = p + 1; hipLaunchKernelGGL(fwd_kernel, dim3(grid), dim3(NWAVES * 64), LDS_BYTES, stream, a); } }
}
```

```cpp
#include <hip/hip_runtime.h>
#include <hip/hip_bf16.h>
#include <cstdio>
#include <cstdint>
#include <cmath>
namespace pg8 {
#define PG8_LAS __attribute__((address_space(3)))
typedef unsigned short bf16_t;
typedef short bf16x8 __attribute__((ext_vector_type(8)));
typedef float f32x4 __attribute__((ext_vector_type(4)));
typedef unsigned u32x4 __attribute__((ext_vector_type(4)));
constexpr int BM = 256, BK = 64, HALF = 128, HTB = HALF * BK * 2  , STAGE_BYTES = 8 * HTB, NXCD = 8, WGM = 8;

__host__ __device__ __forceinline__ int lds_byte(int r, int c) { const int st = (r >> 4) * 2 + (c >> 5), rr = r & 15, cc = c & 31, ob = rr * 64 + cc * 2; return st * 1024 + (ob ^ (((ob >> 9) & 1) << 5)); }
__host__ __device__ __forceinline__ void stage_rc(int b, int& R, int& C) { const int st = b / 1024, sb = b % 1024, swz = sb ^ (((sb >> 9) & 1) << 5); R = (st >> 1) * 16 + swz / 64; C = (st & 1) * 32 + (swz % 64) / 2; }
__host__ __device__ __forceinline__ int perm32(int rho) { const int n = rho >> 4, i = rho & 15; return 8 * (i >> 2) + 4 * n + (i & 3); }

struct Unit { int pm, pn; };
struct Gemm { const bf16_t* A; const bf16_t* Bt; int M, N, K; };

struct StaticOrder {
    int nM, nN, nwg, G, c;
    __host__ __device__ void init(int M, int N, int G_, int c_) { nM = M / BM; nN = N / BM; nwg = nM * nN; G = G_; c = c_; }
    __host__ __device__ bool next(int i, Unit& u) const {
        const long L = (long)i * G + c; if (L >= nwg) return false;
        int wgid = (int)L; { const int q = nwg / NXCD, r = nwg % NXCD, xcd = wgid % NXCD, off = wgid / NXCD; wgid = (xcd < r ? xcd * (q + 1) : r * (q + 1) + (xcd - r) * q) + off; }
        const int nig = WGM * nN, gid = wgid / nig, fm = gid * WGM, gsz = (nM - fm) < WGM ? (nM - fm) : WGM;
        u.pm = fm + ((wgid % nig) % gsz); u.pn = (wgid % nig) / gsz; return true;
    }
    __device__ __forceinline__ void a_ready(const Unit&) const {}
    __device__ __forceinline__ void done(const Unit&) const {}
};

__device__ __forceinline__ unsigned cvt_pk_bf16(float lo, float hi) { unsigned r; asm volatile("v_cvt_pk_bf16_f32 %0, %1, %2" : "=v"(r) : "v"(lo), "v"(hi)); return r; }
typedef float f32x2 __attribute__((ext_vector_type(2)));
struct EpiBf16 {
    static constexpr bool PERM = true, AFTER_DRAIN = false;
    bf16_t* O; int ldc;
    __device__ __forceinline__ void operator()(const f32x4 (&acc)[2][2][4][2], const Unit& u, int wr, int wc, int fr, int fq) const {
        const int row0 = u.pm * BM + wr * 64 + fr; const int col0 = u.pn * BM + wc * 32 + 8 * fq;
#pragma unroll
        for (int ai = 0; ai < 2; ++ai)
#pragma unroll
            for (int m = 0; m < 4; ++m) { bf16_t* rowp = O + (size_t)(row0 + ai * HALF + m * 16) * ldc + col0;
#pragma unroll
                for (int bj = 0; bj < 2; ++bj) { const f32x4 v0 = acc[ai][bj][m][0], v1 = acc[ai][bj][m][1];
                    u32x4 w; w.x = cvt_pk_bf16(v0[0], v0[1]); w.y = cvt_pk_bf16(v0[2], v0[3]); w.z = cvt_pk_bf16(v1[0], v1[1]); w.w = cvt_pk_bf16(v1[2], v1[3]);
                    *(u32x4*)(rowp + bj * HALF) = w; } }
    }
};
struct EpiF32 {
    static constexpr bool PERM = false, AFTER_DRAIN = false;
    float* O; int ldc;
    __device__ __forceinline__ void operator()(const f32x4 (&acc)[2][2][4][2], const Unit& u, int wr, int wc, int fr, int fq) const {
        const int row0 = u.pm * BM + wr * 64 + fr; const int col0 = u.pn * BM + wc * 32 + 4 * fq;
#pragma unroll
        for (int ai = 0; ai < 2; ++ai)
#pragma unroll
            for (int m = 0; m < 4; ++m) { float* rowp = O + (size_t)(row0 + ai * HALF + m * 16) * ldc + col0;
#pragma unroll
                for (int bj = 0; bj < 2; ++bj)
#pragma unroll
                    for (int n = 0; n < 2; ++n) *(f32x4*)(rowp + bj * HALF + n * 16) = acc[ai][bj][m][n]; }
    }
};
struct EpiY {
    static constexpr bool PERM = false, AFTER_DRAIN = false;
    const float* X; const float* gate;   int gstride; float* Y; float alpha;
    __device__ __forceinline__ void operator()(const f32x4 (&acc)[2][2][4][2], const Unit& u, int wr, int wc, int fr, int fq) const {
        const int row0 = u.pm * BM + wr * 64 + fr; const int col0 = u.pn * BM + wc * 32 + 4 * fq;
        const float* gp = gate + (size_t)((u.pm * BM) >> 11) * gstride + col0;
        f32x4 gv[2][2];
#pragma unroll
        for (int bj = 0; bj < 2; ++bj)
#pragma unroll
            for (int n = 0; n < 2; ++n) gv[bj][n] = *(const f32x4*)(gp + bj * HALF + n * 16) + 1.0f;
#pragma unroll
        for (int ai = 0; ai < 2; ++ai)
#pragma unroll
            for (int m = 0; m < 4; ++m) { const size_t off = (size_t)(row0 + ai * HALF + m * 16) * 1024 + col0;
#pragma unroll
                for (int bj = 0; bj < 2; ++bj)
#pragma unroll
                    for (int n = 0; n < 2; ++n) { const f32x4 xv = *(const f32x4*)(X + off + bj * HALF + n * 16);
                        *(f32x4*)(Y + off + bj * HALF + n * 16) = xv * alpha + gv[bj][n] * acc[ai][bj][m][n]; } }
    }
};

template <class Epi, class Sched, bool ALIGN_EPI = false, bool SP2 = false>
__device__ __forceinline__ void gemm_phase(PG8_LAS unsigned char* lds, const Gemm g, const Sched& S, const Epi& E) {
    const int tid = threadIdx.x, wid = __builtin_amdgcn_readfirstlane(tid >> 6), lane = tid & 63, wr = wid >> 2, wc = wid & 3, fr = lane & 15, fq = lane >> 4;
    const int K = g.K, nt = K / BK;
    unsigned voffA[2], voffB[2];
#pragma unroll
    for (int i = 0; i < 2; ++i) { int R, C; stage_rc(tid * 16 + i * 8192, R, C); const int Rb = Epi::PERM ? ((R & ~31) + perm32(R & 31)) : R;
        voffA[i] = (unsigned)(R * K + C) * 2u; voffB[i] = (unsigned)(Rb * K + C) * 2u; }
    const size_t kstep = (size_t)(BK * 2);
    const size_t hstep = (size_t)HALF * K * 2;
    const size_t tstep = 2 * hstep;
    const unsigned ldsw = (unsigned)wid * 1024u;
    const int aoff = lds_byte(wr * 64 + fr, fq * 8), boff = lds_byte(wc * 32 + fr, fq * 8);
#define PG8_SA(b, h) (((b) * 2 + (h)) * HTB)
#define PG8_SB(b, h) ((4 + (b) * 2 + (h)) * HTB)
#define PG8_STAGE(bufoff, gbase, voff) do { _Pragma("unroll") for (int _i = 0; _i < 2; ++_i) \
        __builtin_amdgcn_global_load_lds((const unsigned*)((const char*)(gbase) + (voff)[_i]), (PG8_LAS unsigned*)(lds + (bufoff) + ldsw + _i * 8192), 16, 0, 0); } while (0)
#define PG8_LDA(dst, b, h) do { _Pragma("unroll") for (int m = 0; m < 4; ++m) _Pragma("unroll") for (int k = 0; k < 2; ++k) dst[m][k] = *(const PG8_LAS bf16x8*)(lds + PG8_SA(b, h) + aoff + m * 2048 + k * 1024); } while (0)
#define PG8_LDB(dst, b, h) do { _Pragma("unroll") for (int n = 0; n < 2; ++n) _Pragma("unroll") for (int k = 0; k < 2; ++k) dst[n][k] = *(const PG8_LAS bf16x8*)(lds + PG8_SB(b, h) + boff + n * 2048 + k * 1024); } while (0)
#define PG8_MMA(ai, bj, At, Bt) do { __builtin_amdgcn_s_setprio(1); _Pragma("unroll") for (int m = 0; m < 4; ++m) _Pragma("unroll") for (int n = 0; n < 2; ++n) _Pragma("unroll") for (int k = 0; k < 2; ++k) \
        acc[ai][bj][m][n] = __builtin_amdgcn_mfma_f32_16x16x32_bf16(Bt[n][k], At[m][k], acc[ai][bj][m][n], 0, 0, 0); __builtin_amdgcn_s_setprio(0); } while (0)
#define PG8_WAIT_V(n) asm volatile("s_waitcnt vmcnt(" #n ")" ::: "memory")
#define PG8_WAIT_L(n) asm volatile("s_waitcnt lgkmcnt(" #n ")" ::: "memory")
#define PG8_BAR __builtin_amdgcn_s_barrier()
#define PG8_SCHED __builtin_amdgcn_sched_barrier(0)
    Unit cur, nxt; int ui = 0;
    if (!S.next(0, cur)) return;
    f32x4 acc[2][2][4][2];
#pragma unroll
    for (int a = 0; a < 2; ++a)
#pragma unroll
        for (int b = 0; b < 2; ++b)
#pragma unroll
            for (int m = 0; m < 4; ++m)
#pragma unroll
                for (int n = 0; n < 2; ++n) acc[a][b][m][n] = (f32x4){0.f, 0.f, 0.f, 0.f};
    bf16x8 At[4][2], B0[2][2], B1[2][2];
    const char* cA = (const char*)g.A + (size_t)cur.pm * tstep; const char* cB = (const char*)g.Bt + (size_t)cur.pn * tstep;
    S.a_ready(cur);
    if constexpr (SP2) {
        PG8_STAGE(PG8_SB(0, 0), cB, voffB); PG8_STAGE(PG8_SB(0, 1), cB + hstep, voffB); PG8_STAGE(PG8_SA(0, 0), cA, voffA); PG8_STAGE(PG8_SA(0, 1), cA + hstep, voffA);
        if (wr == 1) PG8_BAR;
        PG8_WAIT_V(2); PG8_BAR;
        PG8_STAGE(PG8_SB(1, 0), cB + kstep, voffB); PG8_STAGE(PG8_SA(1, 0), cA + kstep, voffA); PG8_STAGE(PG8_SB(1, 1), cB + hstep + kstep, voffB);
        PG8_WAIT_V(6); PG8_BAR;
    } else {
        PG8_STAGE(PG8_SB(0, 0), cB, voffB); PG8_STAGE(PG8_SA(0, 0), cA, voffA); PG8_STAGE(PG8_SB(0, 1), cB + hstep, voffB); PG8_STAGE(PG8_SA(0, 1), cA + hstep, voffA);
        if (wr == 1) PG8_BAR;
        PG8_WAIT_V(4); PG8_BAR;
        PG8_STAGE(PG8_SB(1, 0), cB + kstep, voffB); PG8_STAGE(PG8_SA(1, 0), cA + kstep, voffA); PG8_STAGE(PG8_SB(1, 1), cB + hstep + kstep, voffB);
        PG8_WAIT_V(6); PG8_BAR;
    }
    for (;;) {
        const bool has_next = S.next(ui + 1, nxt);
        const char* nA = has_next ? (const char*)g.A + (size_t)nxt.pm * tstep : cA; const char* nB = has_next ? (const char*)g.Bt + (size_t)nxt.pn * tstep : cB;
        for (int t = 0; t < nt; t += 2) {
            const bool last = (t == nt - 2);
            const char* a1 = cA + (size_t)(t + 1) * kstep;
            const char* a2 = last ? nA : cA + (size_t)(t + 2) * kstep; const char* b2 = last ? nB : cB + (size_t)(t + 2) * kstep;
            const char* a3 = a2 + kstep; const char* b3 = b2 + kstep;
            if (last && has_next) S.a_ready(nxt);
            if constexpr (SP2) {
            PG8_LDB(B0, 0, 0); PG8_LDB(B1, 0, 1); PG8_SCHED; PG8_LDA(At, 0, 0); PG8_STAGE(PG8_SA(1, 1), a1 + hstep, voffA);
            PG8_WAIT_V(8); PG8_WAIT_L(0); PG8_BAR; PG8_MMA(0, 0, At, B0); PG8_MMA(0, 1, At, B1); PG8_BAR; PG8_SCHED;
            PG8_LDA(At, 0, 1); PG8_STAGE(PG8_SB(0, 0), b2, voffB); PG8_STAGE(PG8_SB(0, 1), b2 + hstep, voffB); PG8_STAGE(PG8_SA(0, 0), a2, voffA);
            PG8_WAIT_V(8); PG8_WAIT_L(0); PG8_BAR; PG8_MMA(1, 0, At, B0); PG8_MMA(1, 1, At, B1); PG8_BAR; PG8_SCHED;
            PG8_LDB(B0, 1, 0); PG8_LDB(B1, 1, 1); PG8_SCHED; PG8_LDA(At, 1, 0); PG8_STAGE(PG8_SA(0, 1), a2 + hstep, voffA);
            PG8_WAIT_V(8); PG8_WAIT_L(0); PG8_BAR; PG8_MMA(0, 0, At, B0); PG8_MMA(0, 1, At, B1); PG8_BAR; PG8_SCHED;
            PG8_LDA(At, 1, 1); PG8_STAGE(PG8_SB(1, 0), b3, voffB); PG8_STAGE(PG8_SB(1, 1), b3 + hstep, voffB); PG8_STAGE(PG8_SA(1, 0), a3, voffA);
            PG8_WAIT_V(8); PG8_WAIT_L(0); PG8_BAR; PG8_MMA(1, 0, At, B0); PG8_MMA(1, 1, At, B1); PG8_BAR; PG8_SCHED;
            } else {
            PG8_LDB(B0, 0, 0); PG8_SCHED; PG8_LDA(At, 0, 0); PG8_STAGE(PG8_SA(1, 1), a1 + hstep, voffA);
            PG8_WAIT_L(8); PG8_BAR; PG8_WAIT_L(0); PG8_MMA(0, 0, At, B0); PG8_BAR; PG8_SCHED;
            PG8_LDB(B1, 0, 1); PG8_STAGE(PG8_SB(0, 0), b2, voffB);
            PG8_BAR; PG8_WAIT_L(0); PG8_MMA(0, 1, At, B1); PG8_BAR;
            PG8_LDA(At, 0, 1); PG8_STAGE(PG8_SA(0, 0), a2, voffA);
            PG8_BAR; PG8_WAIT_L(0); PG8_MMA(1, 0, At, B0); PG8_BAR; PG8_SCHED;
            PG8_STAGE(PG8_SB(0, 1), b2 + hstep, voffB);
            PG8_WAIT_V(6); PG8_BAR; PG8_MMA(1, 1, At, B1); PG8_BAR;
            PG8_LDB(B0, 1, 0); PG8_SCHED; PG8_LDA(At, 1, 0); PG8_STAGE(PG8_SA(0, 1), a2 + hstep, voffA);
            PG8_WAIT_L(8); PG8_BAR; PG8_WAIT_L(0); PG8_MMA(0, 0, At, B0); PG8_BAR; PG8_SCHED;
            PG8_LDB(B1, 1, 1); PG8_STAGE(PG8_SB(1, 0), b3, voffB);
            PG8_BAR; PG8_WAIT_L(0); PG8_MMA(0, 1, At, B1); PG8_BAR;
            PG8_LDA(At, 1, 1); PG8_STAGE(PG8_SA(1, 0), a3, voffA);
            PG8_BAR; PG8_WAIT_L(0); PG8_MMA(1, 0, At, B0); PG8_BAR; PG8_SCHED;
            PG8_STAGE(PG8_SB(1, 1), b3 + hstep, voffB);
            PG8_WAIT_V(6); PG8_BAR; PG8_MMA(1, 1, At, B1); PG8_BAR;
            }
        }
        if constexpr (ALIGN_EPI) { if (wr == 0) PG8_BAR; }
        if constexpr (!Epi::AFTER_DRAIN) { E(acc, cur, wr, wc, fr, fq); S.done(cur); }
        if (!has_next) break;
#pragma unroll
        for (int a = 0; a < 2; ++a)
#pragma unroll
            for (int b = 0; b < 2; ++b)
#pragma unroll
                for (int m = 0; m < 4; ++m)
#pragma unroll
                    for (int n = 0; n < 2; ++n) acc[a][b][m][n] = (f32x4){0.f, 0.f, 0.f, 0.f};
        cur = nxt; cA = nA; cB = nB; ++ui;
        if constexpr (ALIGN_EPI) { if (wr == 1) PG8_BAR; }
    }
    PG8_WAIT_V(0);
    if constexpr (!ALIGN_EPI) { if (wr == 0) PG8_BAR; }
    PG8_BAR;
    if constexpr (Epi::AFTER_DRAIN) { E.fused(acc, cur, wr, wc, fr, fq, lds, wid, lane); S.done(cur); }
#undef PG8_SA
#undef PG8_SB
#undef PG8_STAGE
#undef PG8_LDA
#undef PG8_LDB
#undef PG8_MMA
#undef PG8_WAIT_V
#undef PG8_WAIT_L
#undef PG8_BAR
#undef PG8_SCHED
}
}
#define GAS __attribute__((address_space(1)))
#define LAS __attribute__((address_space(3)))
typedef unsigned short bf16;
typedef unsigned v4u __attribute__((ext_vector_type(4)));
typedef float f32x4 __attribute__((ext_vector_type(4)));
typedef short bf16x8 __attribute__((ext_vector_type(8)));
typedef GAS unsigned gu32;
typedef GAS unsigned long long gu64;
#define RLX_AGENT __ATOMIC_RELAXED, __HIP_MEMORY_SCOPE_AGENT
#define LDS_WAIT() asm volatile("s_waitcnt lgkmcnt(0)" ::: "memory")
#define VM_WAIT() asm volatile("s_waitcnt vmcnt(0)" ::: "memory")
__device__ __forceinline__ unsigned long long rt() { return __builtin_amdgcn_s_memrealtime(); }
__device__ __forceinline__ unsigned f2bf(float f) { unsigned u = __builtin_bit_cast(unsigned, f); return (u + 0x7fffu + ((u >> 16) & 1u)) >> 16; }
__device__ __forceinline__ unsigned pk2(float lo, float hi) { return f2bf(lo) | (f2bf(hi) << 16); }

#define XB_TMO      128
#define XB_XCNT(j)  (256  + 64 * (j))
#define XB_XSUB(j)  (1280 + 64 * (j))
#define XB_XGEN(j)  (2304 + 64 * (j))
#define XB_TOP      3328
#define XB_TOPGEN   3392
#define XCD_BAR_WORDS 3456
#define XB_SPIN_CAP (1u << 18)

__device__ __forceinline__ unsigned xb_ld(unsigned* p)              { return __hip_atomic_load(p, __ATOMIC_RELAXED, __HIP_MEMORY_SCOPE_AGENT); }
__device__ __forceinline__ unsigned xb_add(unsigned* p, unsigned v) { return __hip_atomic_fetch_add(p, v, __ATOMIC_RELAXED, __HIP_MEMORY_SCOPE_AGENT); }
__device__ __forceinline__ unsigned xb_xcc_id() { return (unsigned)__builtin_amdgcn_s_getreg((3 << 11) | 20) & 0xFu; }
#define XB_SPIN(cond, bar) do { unsigned _sp = 0; while (cond) { __builtin_amdgcn_s_sleep(1); \
    if ((++_sp & 255u) == 0u) { if (xb_ld(&(bar)[XB_TMO])) break; if (_sp > XB_SPIN_CAP) { atomicAdd(&(bar)[XB_TMO], 1u); break; } } } } while (0)

struct XcdBarrier {
    unsigned* bar; unsigned x;
    volatile LAS unsigned* st;
};

__device__ __forceinline__ XcdBarrier xcd_barrier_post(unsigned* bar, volatile LAS unsigned* st) {
    XcdBarrier b; b.bar = bar; b.x = xb_xcc_id(); b.st = st;
    if (threadIdx.x == 0) (void)xb_add(&bar[XB_XCNT(b.x)], 1u);
    return b;
}
__device__ __forceinline__ void xcd_barrier_complete(unsigned* bar, unsigned x, unsigned& nloc, unsigned& nx) {
    const unsigned G = gridDim.x * gridDim.y * gridDim.z;
    unsigned sum, cnt, mine, sp = 0u;
    for (;;) {
        sum = 0u; cnt = 0u; mine = 0u;
#pragma unroll
        for (unsigned j = 0; j < 16; ++j) { const unsigned c = xb_ld(&bar[XB_XCNT(j)]); sum += c; cnt += (c > 0u) ? 1u : 0u; mine = (j == x) ? c : mine; }
        if (sum == G) break;
        __builtin_amdgcn_s_sleep(1);
        if ((++sp & 255u) == 0u) { if (xb_ld(&bar[XB_TMO])) break; if (sp > XB_SPIN_CAP) { atomicAdd(&bar[XB_TMO], 1u); break; } }
    }
    nloc = mine > 0u ? mine : 1u; nx = cnt > 0u ? cnt : 1u;
}

__device__ __forceinline__ void xcd_barrier(const XcdBarrier& b) {
    asm volatile("s_waitcnt vmcnt(0)" ::: "memory");
    __syncthreads();
    if (threadIdx.x == 0) {
        unsigned* bar = b.bar;
        __builtin_amdgcn_s_waitcnt(0);
        unsigned nloc = b.st[0], nx = b.st[1];
        if (nloc == 0u) { xcd_barrier_complete(bar, b.x, nloc, nx); b.st[0] = nloc; b.st[1] = nx; }
        const unsigned old = xb_add(&bar[XB_XSUB(b.x)], 1u);
        const unsigned gen = old / nloc;
        if (old + 1u == (gen + 1u) * nloc) {
            __builtin_amdgcn_fence(__ATOMIC_RELEASE, "agent");
            asm volatile("s_waitcnt vmcnt(0)" ::: "memory");
            const unsigned og = xb_add(&bar[XB_TOP], 1u);
            const unsigned tg = og / nx;
            if (og + 1u == (tg + 1u) * nx) xb_add(&bar[XB_TOPGEN], 1u);
            else XB_SPIN(xb_ld(&bar[XB_TOPGEN]) == tg, bar);
            __builtin_amdgcn_fence(__ATOMIC_ACQUIRE, "agent");
            xb_add(&bar[XB_XGEN(b.x)], 1u);
            asm volatile("s_waitcnt vmcnt(0)" ::: "memory");
        } else {
            XB_SPIN(xb_ld(&bar[XB_XGEN(b.x)]) == gen, bar);
            __builtin_amdgcn_fence(__ATOMIC_ACQUIRE, "agent");
            asm volatile("s_waitcnt vmcnt(0)" ::: "memory");
        }
    }
    __syncthreads();
}

#ifndef MK_N_LAUNCHES
#define MK_N_LAUNCHES 1
#endif
#ifndef PROBE_EXTRA_MASK
#define PROBE_EXTRA_MASK 0
#endif
#ifndef PROBE_SUB
#define PROBE_SUB 3
#endif
#ifndef PROBE_TIME_PHASE
#define PROBE_TIME_PHASE -1
#endif
constexpr int CW_TIME = 512;
constexpr int N_PHASES = 12;
constexpr int N_LAUNCHES = MK_N_LAUNCHES;
constexpr int NWAVES = 8;
constexpr int NB = 8, SEQ = 2048, DM = 1024, MTOK = NB * SEQ;
constexpr float LN_EPS = 1e-5f;
constexpr float DN_ALPHA = 1.189207115002721f;
constexpr float LOG2E = 1.4426950408889634f;
constexpr float QSCALE = 0.125f * LOG2E;
constexpr float LAMBDA_INIT = 0.2f;
constexpr int MODS = 6 * DM;

constexpr size_t MiB = 1u << 20;
constexpr size_t WS_CTL = 0, CTL_ZERO_BYTES = 65536;
constexpr size_t WS_MOD = 1 * MiB;
constexpr size_t WS_WQK = 2 * MiB, WS_WV = 6 * MiB, WS_WO = 8 * MiB, WS_WC = 10 * MiB;
constexpr size_t WS_SDN = 1 * MiB + 256 * 1024, WS_SUP = 1 * MiB + 320 * 1024;
constexpr size_t WS_TDN = 16 * MiB, WS_TUP = 32 * MiB;
constexpr size_t WS_IDG = 48 * MiB, WS_CW = 64 * MiB;
constexpr size_t WS_H2 = 80 * MiB;
constexpr size_t WS_P = 176 * MiB;
constexpr size_t WS_F = 112 * MiB;
constexpr int QKP = 2048 + 64, VTP = MTOK + 64;
constexpr size_t WS_XN = 112 * MiB, WS_QK = 144 * MiB, WS_VT = 211 * MiB;
constexpr size_t WS_CC = 112 * MiB, WS_Y = 144 * MiB, WS_ST = 112 * MiB;
constexpr size_t WS_END = 244 * MiB;
constexpr int CW_BAR = 1024;

constexpr int RING_BYTES = 131072;
constexpr int LDSCTL_OFF = RING_BYTES, MISC_OFF = LDSCTL_OFF + 320;
constexpr int LDS_BYTES = 147456;

typedef float f32x16 __attribute__((ext_vector_type(16)));
typedef float f32x2v __attribute__((ext_vector_type(2)));
typedef unsigned u32x2 __attribute__((ext_vector_type(2)));
typedef __bf16 bf16x2_t __attribute__((ext_vector_type(2)));

__device__ __forceinline__ unsigned cvtpk(float lo, float hi) { f32x2v v = {lo, hi}; bf16x2_t b = __builtin_convertvector(v, bf16x2_t); return __builtin_bit_cast(unsigned, b); }
__device__ __forceinline__ float bf_lo(unsigned w) { return __builtin_bit_cast(float, w << 16); }
__device__ __forceinline__ float bf_hi(unsigned w) { return __builtin_bit_cast(float, w & 0xffff0000u); }
__device__ __forceinline__ float wave_sum(float v) {
#pragma unroll
    for (int o = 1; o < 64; o <<= 1) v += __shfl_xor(v, o);
    return v;
}
__device__ __forceinline__ float dot2bf(unsigned w, unsigned x, float acc) { return __builtin_amdgcn_fdot2_f32_bf16(__builtin_bit_cast(bf16x2_t, w), __builtin_bit_cast(bf16x2_t, x), acc, false); }

__device__ __forceinline__ void phase_mod(const float* c, const float* w_ada, const float* b_ada, float* mod, unsigned char* lds, int tid, int lane, int wave) {
    float* sc = (float*)lds;
    float* red = (float*)(lds + 32768);
    bool did = false;
    for (int item = blockIdx.x; item < MODS / 64; item += gridDim.x) {
        if (!did) { for (int i = tid; i < NB * DM; i += 512) { const float v = c[i]; sc[i] = v / (1.f + __expf(-v)); } __syncthreads(); did = true; }
        const int e0 = item * 64, cg = lane & 15, rs = lane >> 4;
        float acc[8][4];
#pragma unroll
        for (int b = 0; b < 8; ++b) { acc[b][0] = 0.f; acc[b][1] = 0.f; acc[b][2] = 0.f; acc[b][3] = 0.f; }
#pragma unroll 4
        for (int it = 0; it < 32; ++it) {
            const int d = wave * 128 + it * 4 + rs;
            const f32x4 wv = *(const f32x4*)(w_ada + (size_t)d * MODS + e0 + 4 * cg);
#pragma unroll
            for (int b = 0; b < 8; ++b) { const float s = sc[b * DM + d]; acc[b][0] += s * wv[0]; acc[b][1] += s * wv[1]; acc[b][2] += s * wv[2]; acc[b][3] += s * wv[3]; }
        }
#pragma unroll
        for (int b = 0; b < 8; ++b)
#pragma unroll
            for (int j = 0; j < 4; ++j) { float v = acc[b][j]; v += __shfl_xor(v, 16); v += __shfl_xor(v, 32); if (rs == 0) red[(wave * 8 + b) * 64 + 4 * cg + j] = v; }
        __syncthreads();
        { const int b = tid >> 6, col = tid & 63; float s = b_ada[e0 + col];
#pragma unroll
          for (int w = 0; w < 8; ++w) s += red[(w * 8 + b) * 64 + col];
          mod[b * MODS + e0 + col] = s; }
        __syncthreads();
    }
}

__device__ __forceinline__ void transpose_item(const float* W, int ldw, int col0, int K, bf16* WT, int row_off, float scale, LAS float* scr, int kb, int nb, int lane) {
    const int k0 = 64 * kb, n0 = 32 * nb;
#pragma unroll 8
    for (int i = 0; i < 32; ++i) { const int kk = 2 * i + (lane >> 5); scr[kk * 33 + (lane & 31)] = W[(size_t)(k0 + kk) * ldw + col0 + n0 + (lane & 31)]; }
    LDS_WAIT(); asm volatile("" ::: "memory");
    const int c = lane & 7;
#pragma unroll
    for (int j = 0; j < 4; ++j) { const int n = (lane >> 3) + 8 * j; const LAS float* s = scr + (8 * c) * 33 + n;
        v4u o; o.x = cvtpk(s[0 * 33] * scale, s[1 * 33] * scale); o.y = cvtpk(s[2 * 33] * scale, s[3 * 33] * scale); o.z = cvtpk(s[4 * 33] * scale, s[5 * 33] * scale); o.w = cvtpk(s[6 * 33] * scale, s[7 * 33] * scale);
        *(v4u*)(WT + (size_t)(row_off + n0 + n) * K + k0 + 8 * c) = o; }
    LDS_WAIT(); asm volatile("" ::: "memory");
}
__device__ __forceinline__ bf16x8 ld8_f32_bf16(const float* p) {
    const f32x4 a = *(const f32x4*)p, b = *(const f32x4*)(p + 4);
    v4u o; o.x = cvtpk(a[0], a[1]); o.y = cvtpk(a[2], a[3]); o.z = cvtpk(b[0], b[1]); o.w = cvtpk(b[2], b[3]);
    return __builtin_bit_cast(bf16x8, o);
}
__device__ __forceinline__ void wc_item(const float* w_query, const float* sub_keys, bf16* WcT, int item, int lane) {
    const int hp = item >> 6, d0 = (item & 63) * 16, p = hp & 1;
    const int r = lane & 15, kg = lane >> 4;
    bf16x8 a[4];
#pragma unroll
    for (int ks = 0; ks < 4; ++ks) a[ks] = ld8_f32_bf16(w_query + (size_t)(d0 + r) * 2048 + hp * 128 + ks * 32 + 8 * kg);
#pragma unroll
    for (int nt = 0; nt < 8; ++nt) {
        f32x4 acc = {0.f, 0.f, 0.f, 0.f};
#pragma unroll
        for (int ks = 0; ks < 4; ++ks) { const bf16x8 b = ld8_f32_bf16(sub_keys + (size_t)(p * 128 + nt * 16 + r) * 128 + ks * 32 + 8 * kg);
            acc = __builtin_amdgcn_mfma_f32_16x16x32_bf16(a[ks], b, acc, 0, 0, 0); }
        u32x2 o; o.x = cvtpk(acc[0], acc[1]); o.y = cvtpk(acc[2], acc[3]);
        *(u32x2*)(WcT + (size_t)(hp * 128 + nt * 16 + r) * DM + d0 + 4 * kg) = o;
    }
}
struct RowStats { float mean, rstd; };
__device__ __forceinline__ RowStats row_stats(const f32x4 (&v)[4]) {
    float s = 0.f;
#pragma unroll
    for (int j = 0; j < 4; ++j) s += (v[j][0] + v[j][1]) + (v[j][2] + v[j][3]);
    const float mean = wave_sum(s) * (1.f / DM); float s2 = 0.f;
#pragma unroll
    for (int j = 0; j < 4; ++j) { const f32x4 d = v[j] - mean; s2 += (d[0] * d[0] + d[1] * d[1]) + (d[2] * d[2] + d[3] * d[3]); }
    RowStats r; r.mean = mean; r.rstd = 1.f / sqrtf(wave_sum(s2) * (1.f / DM) + LN_EPS); return r;
}
__device__ __forceinline__ void phase_prologue(const float* const* in, unsigned char* ws, LAS unsigned char* lds, int lane, int wave) {
    const float* x = in[0]; const float* w_in = in[4]; const float* w_out = in[5]; const float* w_query = in[15]; const float* sub_keys = in[16];
    const float* mod = (const float*)(ws + WS_MOD);
    LAS float* scr = (LAS float*)(lds + wave * 16384);
    const int gw = blockIdx.x * NWAVES + wave, NGW = gridDim.x * NWAVES;
    for (int it = gw; it < 2048; it += NGW) {
        const int seg = it >> 8, r = it & 255, kb = r >> 4, nb = r & 15;
        switch (seg) {
            case 0: transpose_item(w_in, 3072, 0, DM, (bf16*)(ws + WS_WQK), 0, QSCALE, scr, kb, nb, lane); break;
            case 1: transpose_item(w_in, 3072, 512, DM, (bf16*)(ws + WS_WQK), 512, 1.f, scr, kb, nb, lane); break;
            case 2: transpose_item(w_in, 3072, 1536, DM, (bf16*)(ws + WS_WQK), 1024, QSCALE, scr, kb, nb, lane); break;
            case 3: transpose_item(w_in, 3072, 2048, DM, (bf16*)(ws + WS_WQK), 1536, 1.f, scr, kb, nb, lane); break;
            case 4: transpose_item(w_in, 3072, 1024, DM, (bf16*)(ws + WS_WV), 0, 1.f, scr, kb, nb, lane); break;
            case 5: transpose_item(w_in, 3072, 2560, DM, (bf16*)(ws + WS_WV), 512, 1.f, scr, kb, nb, lane); break;
            case 6: transpose_item(w_out, 1024, 0, DM, (bf16*)(ws + WS_WO), 0, 1.f, scr, kb, nb, lane); break;
            default: transpose_item(w_out, 1024, 512, DM, (bf16*)(ws + WS_WO), 512, 1.f, scr, kb, nb, lane); break;
        }
    }
    for (int it = gw; it < 1024; it += NGW) wc_item(w_query, sub_keys, (bf16*)(ws + WS_WC), it, lane);
    if (gw < MTOK) {
        f32x4 v[4], vn[4];
        { const f32x4* xr = (const f32x4*)(x + (size_t)gw * DM) + lane;
#pragma unroll
          for (int j = 0; j < 4; ++j) v[j] = xr[64 * j]; }
        for (int m = gw; m < MTOK; m += NGW) {
            if (m + NGW < MTOK) { const f32x4* xr = (const f32x4*)(x + (size_t)(m + NGW) * DM) + lane;
#pragma unroll
                for (int j = 0; j < 4; ++j) vn[j] = xr[64 * j]; }
            const int b = m >> 11; const float* sh = mod + b * MODS; const float* scp = sh + DM;
            const RowStats st = row_stats(v);
            u32x2* o8 = (u32x2*)((bf16*)(ws + WS_XN) + (size_t)m * DM) + lane;
#pragma unroll
            for (int j = 0; j < 4; ++j) { const f32x4 s4 = *((const f32x4*)scp + lane + 64 * j), h4 = *((const f32x4*)sh + lane + 64 * j);
                const f32x4 y = (v[j] - st.mean) * st.rstd * (s4 + 1.0f) + h4; u32x2 o; o.x = cvtpk(y[0], y[1]); o.y = cvtpk(y[2], y[3]); o8[64 * j] = o; }
#pragma unroll
            for (int j = 0; j < 4; ++j) v[j] = vn[j];
        }
    }
    f32x4 ev[4], evn[4];
    { const float* src0 = in[17] + (size_t)gw * DM + 16 * lane;
#pragma unroll
      for (int j = 0; j < 4; ++j) ev[j] = *(const f32x4*)(src0 + 4 * j); }
    for (int rr = gw; rr < 32768; rr += NGW) {
        const bool up = rr >= 16384; const int e = up ? rr - 16384 : rr;
        if (rr + NGW < 32768) { const int rn = rr + NGW; const float* srcn = (rn >= 16384 ? in[18] + (size_t)(rn - 16384) * DM : in[17] + (size_t)rn * DM) + 16 * lane;
#pragma unroll
            for (int j = 0; j < 4; ++j) evn[j] = *(const f32x4*)(srcn + 4 * j); }
        f32x4 v[4]; float am = 0.f;
#pragma unroll
        for (int j = 0; j < 4; ++j) { v[j] = ev[j]; ev[j] = evn[j]; am = fmaxf(am, fmaxf(fmaxf(fabsf(v[j][0]), fabsf(v[j][1])), fmaxf(fabsf(v[j][2]), fabsf(v[j][3])))); }
#pragma unroll
        for (int o = 1; o < 64; o <<= 1) am = fmaxf(am, __shfl_xor(am, o));
        const float sc = am > 0.f ? 384.f / am : 1.f;
        v4u q;
        { int w = 0; w = __builtin_amdgcn_cvt_pk_fp8_f32(v[0][0] * sc, v[0][1] * sc, w, false); w = __builtin_amdgcn_cvt_pk_fp8_f32(v[0][2] * sc, v[0][3] * sc, w, true); q.x = (unsigned)w; }
        { int w = 0; w = __builtin_amdgcn_cvt_pk_fp8_f32(v[1][0] * sc, v[1][1] * sc, w, false); w = __builtin_amdgcn_cvt_pk_fp8_f32(v[1][2] * sc, v[1][3] * sc, w, true); q.y = (unsigned)w; }
        { int w = 0; w = __builtin_amdgcn_cvt_pk_fp8_f32(v[2][0] * sc, v[2][1] * sc, w, false); w = __builtin_amdgcn_cvt_pk_fp8_f32(v[2][2] * sc, v[2][3] * sc, w, true); q.z = (unsigned)w; }
        { int w = 0; w = __builtin_amdgcn_cvt_pk_fp8_f32(v[3][0] * sc, v[3][1] * sc, w, false); w = __builtin_amdgcn_cvt_pk_fp8_f32(v[3][2] * sc, v[3][3] * sc, w, true); q.w = (unsigned)w; }
        if (!up) { *(v4u*)(ws + WS_TDN + ((size_t)(lane >> 3) * 16384 + e) * 128 + 16 * (lane & 7)) = q; if (lane == 0) ((float*)(ws + WS_SDN))[e] = am > 0.f ? am * (1.f / 384.f) : 1.f; }
        else { *(v4u*)(ws + WS_TUP + ((size_t)(lane >> 3) * 16384 + e) * 128 + 16 * (lane & 7)) = q; if (lane == 0) ((float*)(ws + WS_SUP))[e] = am > 0.f ? am * (1.f / 384.f) : 1.f; }
    }
}

constexpr int ATT_KSTR = 144, ATT_VSTR = 136;
constexpr int ATT_K0 = 0, ATT_K1 = 64 * ATT_KSTR, ATT_V = 2 * 64 * ATT_KSTR, ATT_BUF = ATT_V + 128 * ATT_VSTR;
constexpr int ATT_TAB = 98304;
constexpr int ATT_RPB_N = 8 * 15 * 31, ATT_T5_N = 4 * 257;
static_assert(2 * ATT_BUF <= 65536 + 8192 && ATT_TAB + (ATT_RPB_N + ATT_T5_N + 4) * 4 <= RING_BYTES, "attention LDS map");

__device__ __forceinline__ int t5_bucket(int rel) {
    const int n = rel < 0 ? -rel : rel; int bucket = rel > 0 ? 16 : 0;
    const float nf = (float)(n < 1 ? 1 : n);
    int large = 8 + (int)(logf(nf / 8.0f) / 2.772588722239781f * 8.0f);
    large = large < 15 ? large : 15;
    return bucket + (n < 8 ? n : large);
}
__device__ __forceinline__ void att_tables(const float* na_rpb, const float* t5_bias, const float* lq1, const float* lk1, const float* lq2, const float* lk2, unsigned char* lds, int tid, int lane, int wave) {
    float* rpbL = (float*)(lds + ATT_TAB); float* t5L = rpbL + ATT_RPB_N; float* lamL = t5L + ATT_T5_N;
    for (int i = tid; i < ATT_RPB_N; i += 512) rpbL[i] = na_rpb[i] * LOG2E;
    for (int i = tid; i < ATT_T5_N; i += 512) { const int h = i / 257, rel = i % 257 - 128; t5L[i] = t5_bias[t5_bucket(rel) * 4 + h] * LOG2E; }
    if (wave == 0) { const float a = wave_sum(lq1[lane] * lk1[lane]), b = wave_sum(lq2[lane] * lk2[lane]); if (lane == 0) lamL[0] = expf(a) - expf(b) + LAMBDA_INIT; }
    __syncthreads();
}

constexpr int NA_KSTR = 144, NA_VSTR = 1168;
static_assert(9 * 64 * NA_KSTR <= ATT_TAB && 64 * NA_VSTR <= ATT_TAB, "NA staging fits below the tables");
__device__ __forceinline__ void na_unit(int unit, const bf16* QK, const bf16* VT, bf16* CC, const float* rpbL, unsigned char* lds, int tid, int lane, int wave) {
    const int rp = unit & 15, h = (unit >> 4) & 7, b = unit >> 7;
    const int r = 2 * rp + (wave >> 2), g = wave & 3;
    const int qi = lane & 15, kg = lane >> 4;
    const int rs = min(max(r - 4, 0), 24), rs_lo = min(max(2 * rp - 4, 0), 24);
    const int nrows = min(9, 32 - rs_lo);
    const int c0 = (g == 0) ? 0 : (g == 1) ? 8 : (g == 2) ? 24 : 32;
    const int qcol = 16 * g + qi, cs = min(max(qcol - 8, 0), 48);
    const size_t tokb = (size_t)b * SEQ;
    v4u st[9];
    { const bf16* kp = QK + (tokb + rs_lo * 64 + (tid >> 3)) * QKP + 512 + h * 64 + (tid & 7) * 8;
#pragma unroll
      for (int j = 0; j < 9; ++j) if (j < nrows) st[j] = *(const v4u*)(kp + (size_t)j * 64 * QKP); }
    const bf16* qp = QK + (tokb + r * 64 + qcol) * QKP + h * 64 + 8 * kg;
    const bf16x8 qf0 = *(const bf16x8*)qp, qf1 = *(const bf16x8*)(qp + 32);
    { unsigned char* kd = lds + (tid >> 3) * NA_KSTR + (tid & 7) * 16;
#pragma unroll
      for (int j = 0; j < 9; ++j) if (j < nrows) *(v4u*)(kd + j * 64 * NA_KSTR) = st[j]; }
    __syncthreads();
    { const bf16* vp = VT + (size_t)(h * 64) * VTP + tokb + rs_lo * 64;
#pragma unroll
      for (int j = 0; j < 9; ++j) { const int c = tid + 512 * j, dh = c / 72, pc = c - dh * 72; if (pc * 8 < nrows * 64) st[j] = *(const v4u*)(vp + (size_t)dh * VTP + pc * 8); } }
    f32x4 s[16];
    { const unsigned char* kb = lds + (((rs - rs_lo) * 64 + c0 + qi) * NA_KSTR) + kg * 16;
#pragma unroll
      for (int t = 0; t < 16; ++t) {
          const int i = t >> 1, half = t & 1;
          const unsigned char* kp = kb + (i * 64 + 16 * half) * NA_KSTR;
          const bf16x8 k0 = *(const bf16x8*)kp, k1 = *(const bf16x8*)(kp + 64);
          f32x4 a = {0.f, 0.f, 0.f, 0.f};
          a = __builtin_amdgcn_mfma_f32_16x16x32_bf16(k0, qf0, a, 0, 0, 0);
          a = __builtin_amdgcn_mfma_f32_16x16x32_bf16(k1, qf1, a, 0, 0, 0);
          s[t] = a;
      } }
    float mx = -INFINITY;
#pragma unroll
    for (int t = 0; t < 16; ++t) {
        const int i = t >> 1, half = t & 1; const float* bp = rpbL + (h * 15 + (rs + i - r + 7)) * 31 + 15;
#pragma unroll
        for (int e = 0; e < 4; ++e) { const int kcol = c0 + 16 * half + 4 * kg + e; const bool valid = (kcol >= cs) && (kcol < cs + 16);
            const int co = min(max(kcol - qcol, -15), 15);
            const float v = valid ? s[t][e] + bp[co] : -INFINITY; s[t][e] = v; mx = fmaxf(mx, v); }
    }
    mx = fmaxf(mx, __shfl_xor(mx, 16)); mx = fmaxf(mx, __shfl_xor(mx, 32));
    float l = 0.f;
#pragma unroll
    for (int t = 0; t < 16; ++t)
#pragma unroll
        for (int e = 0; e < 4; ++e) { const float p = __builtin_amdgcn_exp2f(s[t][e] - mx); s[t][e] = p; l += p; }
    l += __shfl_xor(l, 16); l += __shfl_xor(l, 32);
    __syncthreads();
#pragma unroll
    for (int j = 0; j < 9; ++j) { const int c = tid + 512 * j, dh = c / 72, pc = c - dh * 72; if (pc * 8 < nrows * 64) *(v4u*)(lds + dh * NA_VSTR + pc * 16) = st[j]; }
    __syncthreads();
    f32x4 o[4];
#pragma unroll
    for (int nt = 0; nt < 4; ++nt) o[nt] = (f32x4){0.f, 0.f, 0.f, 0.f};
    { const unsigned char* vb = lds + qi * NA_VSTR + ((rs - rs_lo) * 64 + c0 + 4 * kg) * 2;
#pragma unroll
      for (int kk = 0; kk < 8; ++kk) {
          v4u pw; pw.x = cvtpk(s[2 * kk][0], s[2 * kk][1]); pw.y = cvtpk(s[2 * kk][2], s[2 * kk][3]); pw.z = cvtpk(s[2 * kk + 1][0], s[2 * kk + 1][1]); pw.w = cvtpk(s[2 * kk + 1][2], s[2 * kk + 1][3]);
          const bf16x8 pb = __builtin_bit_cast(bf16x8, pw);
#pragma unroll
          for (int nt = 0; nt < 4; ++nt) {
              const unsigned char* vp = vb + nt * 16 * NA_VSTR + kk * 128;
              const u32x2 lo = *(const u32x2*)vp, hi = *(const u32x2*)(vp + 32);
              v4u aw; aw.x = lo.x; aw.y = lo.y; aw.z = hi.x; aw.w = hi.y;
              o[nt] = __builtin_amdgcn_mfma_f32_16x16x32_bf16(__builtin_bit_cast(bf16x8, aw), pb, o[nt], 0, 0, 0);
          }
      } }
    const float inv = 1.f / l;
    bf16* op = CC + (tokb + r * 64 + qcol) * DM + h * 64 + 4 * kg;
#pragma unroll
    for (int nt = 0; nt < 4; ++nt) { u32x2 w; w.x = cvtpk(o[nt][0] * inv, o[nt][1] * inv); w.y = cvtpk(o[nt][2] * inv, o[nt][3] * inv); *(u32x2*)(op + nt * 16) = w; }
    __syncthreads();
}

__device__ __forceinline__ int crow(int r, int hi) { return (r & 3) + 8 * (r >> 2) + 4 * hi; }

__device__ __forceinline__ void diff_unit(int unit, const bf16* QK, const bf16* VT, bf16* CC, const float* subln, unsigned char* lds, int tid, int lane, int wave) {
    const int qb = unit & 15, h = (unit >> 4) & 3, b = unit >> 6;
    const int mp = wave >> 2, qs = wave & 3, r32 = lane & 31, hi = lane >> 5;
    const size_t tokb = (size_t)b * SEQ;
    const int q0 = qb * 128 + qs * 32;
    const float* t5L = (const float*)(lds + ATT_TAB) + ATT_RPB_N + h * 257 + 128;
    const float lam = ((const float*)(lds + ATT_TAB))[ATT_RPB_N + ATT_T5_N];
    const float cL = t5L[-128], cR = t5L[128];
    bf16x8 qf[4];
    { const bf16* qp = QK + (tokb + q0 + r32) * QKP + 1024 + h * 128 + mp * 64 + 8 * hi;
#pragma unroll
      for (int d0 = 0; d0 < 4; ++d0) qf[d0] = *(const bf16x8*)(qp + d0 * 16); }
    const bf16* ksrc = QK + (tokb + (tid >> 3)) * QKP + 1536 + h * 128 + (tid & 7) * 8;
    const bf16* vsrc = VT + (size_t)(512 + h * 128 + (tid >> 3)) * VTP + tokb + (tid & 7) * 8;
    const int kdst = (tid >> 3) * ATT_KSTR + (tid & 7) * 16, vdst = ATT_V + (tid >> 3) * ATT_VSTR + (tid & 7) * 16;
    v4u sk[2], sv[2];
#define DIFF_LOAD(t) do { sk[0] = *(const v4u*)(ksrc + (size_t)(t) * 64 * QKP); sk[1] = *(const v4u*)(ksrc + (size_t)(t) * 64 * QKP + 64); \
        sv[0] = *(const v4u*)(vsrc + (t) * 64); sv[1] = *(const v4u*)(vsrc + (size_t)64 * VTP + (t) * 64); } while (0)
#define DIFF_STORE(buf) do { unsigned char* bb_ = lds + (buf) * ATT_BUF; *(v4u*)(bb_ + ATT_K0 + kdst) = sk[0]; *(v4u*)(bb_ + ATT_K1 + kdst) = sk[1]; \
        *(u32x2*)(bb_ + vdst) = (u32x2){sv[0].x, sv[0].y}; *(u32x2*)(bb_ + vdst + 8) = (u32x2){sv[0].z, sv[0].w}; \
        *(u32x2*)(bb_ + vdst + 64 * ATT_VSTR) = (u32x2){sv[1].x, sv[1].y}; *(u32x2*)(bb_ + vdst + 64 * ATT_VSTR + 8) = (u32x2){sv[1].z, sv[1].w}; } while (0)
    DIFF_LOAD(0); DIFF_STORE(0); __syncthreads();
    f32x16 o[4];
#pragma unroll
    for (int k = 0; k < 4; ++k)
#pragma unroll
        for (int e = 0; e < 16; ++e) o[k][e] = 0.f;
    float m_run = -1e30f, l_run = 0.f;
    const int qpos = q0 + r32;
    for (int t = 0; t < SEQ / 64; ++t) {
        if (t + 1 < SEQ / 64) DIFF_LOAD(t + 1);
        const unsigned char* bb = lds + (t & 1) * ATT_BUF;
        const unsigned char* kb_ = bb + (mp ? ATT_K1 : ATT_K0) + r32 * ATT_KSTR + hi * 16;
        const bool farL = (64 * t + 63 - q0) <= -91, farR = (64 * t - (q0 + 31)) >= 91;
        const float cinit = farL ? cL : (farR ? cR : 0.f);
        f32x16 p0, p1;
#pragma unroll
        for (int e = 0; e < 16; ++e) { p0[e] = cinit; p1[e] = cinit; }
#pragma unroll
        for (int d0 = 0; d0 < 4; ++d0) {
            const bf16x8 ka = *(const bf16x8*)(kb_ + d0 * 32), kc = *(const bf16x8*)(kb_ + 32 * ATT_KSTR + d0 * 32);
            p0 = __builtin_amdgcn_mfma_f32_32x32x16_bf16(ka, qf[d0], p0, 0, 0, 0);
            p1 = __builtin_amdgcn_mfma_f32_32x32x16_bf16(kc, qf[d0], p1, 0, 0, 0);
        }
        if (!(farL || farR)) {
            const int rel0 = 64 * t - qpos;
#pragma unroll
            for (int e = 0; e < 16; ++e) { const int ra = rel0 + crow(e, hi); const int rb = ra + 32;
                p0[e] += t5L[min(max(ra, -128), 128)]; p1[e] += t5L[min(max(rb, -128), 128)]; }
        }
        float mx = p0[0];
#pragma unroll
        for (int e = 1; e < 16; ++e) mx = fmaxf(mx, p0[e]);
#pragma unroll
        for (int e = 0; e < 16; ++e) mx = fmaxf(mx, p1[e]);
        mx = fmaxf(mx, __shfl_xor(mx, 32));
        const float m_new = fmaxf(m_run, mx), alpha = __builtin_amdgcn_exp2f(m_run - m_new);
        m_run = m_new;
        float ls = 0.f;
#pragma unroll
        for (int e = 0; e < 16; ++e) { p0[e] = __builtin_amdgcn_exp2f(p0[e] - m_new); p1[e] = __builtin_amdgcn_exp2f(p1[e] - m_new); ls += p0[e] + p1[e]; }
        l_run = l_run * alpha + ls;
#pragma unroll
        for (int k = 0; k < 4; ++k)
#pragma unroll
            for (int e = 0; e < 16; ++e) o[k][e] *= alpha;
        bf16x8 pf[4];
        { v4u w;
          w.x = cvtpk(p0[0], p0[1]); w.y = cvtpk(p0[2], p0[3]); w.z = cvtpk(p0[4], p0[5]); w.w = cvtpk(p0[6], p0[7]); pf[0] = __builtin_bit_cast(bf16x8, w);
          w.x = cvtpk(p0[8], p0[9]); w.y = cvtpk(p0[10], p0[11]); w.z = cvtpk(p0[12], p0[13]); w.w = cvtpk(p0[14], p0[15]); pf[1] = __builtin_bit_cast(bf16x8, w);
          w.x = cvtpk(p1[0], p1[1]); w.y = cvtpk(p1[2], p1[3]); w.z = cvtpk(p1[4], p1[5]); w.w = cvtpk(p1[6], p1[7]); pf[2] = __builtin_bit_cast(bf16x8, w);
          w.x = cvtpk(p1[8], p1[9]); w.y = cvtpk(p1[10], p1[11]); w.z = cvtpk(p1[12], p1[13]); w.w = cvtpk(p1[14], p1[15]); pf[3] = __builtin_bit_cast(bf16x8, w); }
        const unsigned char* vb_ = bb + ATT_V + r32 * ATT_VSTR + hi * 8;
#pragma unroll
        for (int blk = 0; blk < 4; ++blk)
#pragma unroll
            for (int ks = 0; ks < 4; ++ks) {
                const unsigned char* vp = vb_ + blk * 32 * ATT_VSTR + ks * 32;
                const u32x2 lo = *(const u32x2*)vp, hv = *(const u32x2*)(vp + 16);
                v4u aw; aw.x = lo.x; aw.y = lo.y; aw.z = hv.x; aw.w = hv.y;
                o[blk] = __builtin_amdgcn_mfma_f32_32x32x16_bf16(__builtin_bit_cast(bf16x8, aw), pf[ks], o[blk], 0, 0, 0);
            }
        if (t + 1 < SEQ / 64) DIFF_STORE((t + 1) & 1);
        __syncthreads();
    }
#undef DIFF_LOAD
#undef DIFF_STORE
    const float ltot = l_run + __shfl_xor(l_run, 32);
    const float inv = (mp ? lam : 1.f) / ltot;
    float* exch = (float*)lds + qs * 4096;
    if (mp == 1) {
#pragma unroll
        for (int k = 0; k < 4; ++k)
#pragma unroll
            for (int e = 0; e < 16; ++e) exch[(k * 16 + e) * 64 + lane] = o[k][e] * inv;
    }
    __syncthreads();
    if (mp == 0) {
        float ss = 0.f;
#pragma unroll
        for (int k = 0; k < 4; ++k)
#pragma unroll
            for (int e = 0; e < 16; ++e) { const float d = o[k][e] * inv - exch[(k * 16 + e) * 64 + lane]; o[k][e] = d; ss += d * d; }
        ss += __shfl_xor(ss, 32);
        const float rn = (1.0f - LAMBDA_INIT) / sqrtf(ss * (1.f / 128.f) + LN_EPS);
        bf16* op = CC + (tokb + q0 + r32) * DM + 512 + h * 128 + 4 * hi;
#pragma unroll
        for (int k = 0; k < 4; ++k)
#pragma unroll
            for (int g4 = 0; g4 < 4; ++g4) { const int dv = k * 32 + 8 * g4 + 4 * hi; const f32x4 sg = *(const f32x4*)(subln + dv);
                u32x2 w; w.x = cvtpk(o[k][4 * g4] * rn * sg[0], o[k][4 * g4 + 1] * rn * sg[1]); w.y = cvtpk(o[k][4 * g4 + 2] * rn * sg[2], o[k][4 * g4 + 3] * rn * sg[3]);
                *(u32x2*)(op + k * 32 + 8 * g4) = w; }
    }
    __syncthreads();
}

__device__ __forceinline__ void phase_attention(const float* const* in, unsigned char* ws, unsigned char* lds, int tid, int lane, int wave, int sub) {
    const bf16* QK = (const bf16*)(ws + WS_QK); const bf16* VT = (const bf16*)(ws + WS_VT); bf16* CC = (bf16*)(ws + WS_CC);
    att_tables(in[6], in[7], in[8], in[9], in[10], in[11], lds, tid, lane, wave);
    const bool xmap = (gridDim.x == 256);
    if (sub & 1) {
        if (xmap) { const int x = blockIdx.x & 7, rk = blockIdx.x >> 3;
            for (int k = 0; k < 2; ++k) { const int idx = rk + 32 * k, pid = x * 4 + (idx >> 4); diff_unit((pid << 4) | (idx & 15), QK, VT, CC, in[12], lds, tid, lane, wave); } }
        else for (int u = blockIdx.x; u < 512; u += gridDim.x) diff_unit(u, QK, VT, CC, in[12], lds, tid, lane, wave);
    }
    const float* rpbL = (const float*)(lds + ATT_TAB);
    if (sub & 2) {
        if (xmap) { const int x = blockIdx.x & 7, rk = blockIdx.x >> 3;
            for (int k = 0; k < 4; ++k) { const int idx = rk + 32 * k; na_unit(((idx >> 4) << 7) | (x << 4) | (idx & 15), QK, VT, CC, rpbL, lds, tid, lane, wave); } }
        else for (int u = blockIdx.x; u < 1024; u += gridDim.x) na_unit(u, QK, VT, CC, rpbL, lds, tid, lane, wave);
    }
}

__device__ __forceinline__ void phase_rows(const float* const* in, unsigned char* ws, float* X1, int lane, int wave) {
    const float* Y = (const float*)(ws + WS_Y); const float* mod = (const float*)(ws + WS_MOD); bf16* H2 = (bf16*)(ws + WS_H2);
    const float* g1 = in[13]; const float* b1 = in[14];
    const int gw = blockIdx.x * NWAVES + wave, NGW = gridDim.x * NWAVES;
    if (gw >= MTOK) return;
    f32x4 v[4], vn[4];
    { const f32x4* yr = (const f32x4*)(Y + (size_t)gw * DM) + lane;
#pragma unroll
      for (int j = 0; j < 4; ++j) v[j] = yr[64 * j]; }
    for (int m = gw; m < MTOK; m += NGW) {
        if (m + NGW < MTOK) { const f32x4* yr = (const f32x4*)(Y + (size_t)(m + NGW) * DM) + lane;
#pragma unroll
            for (int j = 0; j < 4; ++j) vn[j] = yr[64 * j]; }
        const int b = m >> 11; const float* sh = mod + b * MODS + 3 * DM; const float* scp = mod + b * MODS + 4 * DM;
        const RowStats s1 = row_stats(v);
        f32x4* xo = (f32x4*)(X1 + (size_t)m * DM) + lane;
#pragma unroll
        for (int j = 0; j < 4; ++j) { const f32x4 gg = *((const f32x4*)g1 + lane + 64 * j), bb = *((const f32x4*)b1 + lane + 64 * j);
            v[j] = (v[j] - s1.mean) * s1.rstd * gg + bb; xo[64 * j] = v[j]; }
        const RowStats s2 = row_stats(v);
        u32x2* o8 = (u32x2*)(H2 + (size_t)m * DM) + lane;
#pragma unroll
        for (int j = 0; j < 4; ++j) { const f32x4 s4 = *((const f32x4*)scp + lane + 64 * j), h4 = *((const f32x4*)sh + lane + 64 * j);
            const f32x4 y = (v[j] - s2.mean) * s2.rstd * (s4 + 1.0f) + h4; u32x2 o; o.x = cvtpk(y[0], y[1]); o.y = cvtpk(y[2], y[3]); o8[64 * j] = o; }
#pragma unroll
        for (int j = 0; j < 4; ++j) v[j] = vn[j];
    }
}

__device__ __forceinline__ unsigned key_enc(float v, int n) { const unsigned u = __builtin_bit_cast(unsigned, v); const unsigned k = u ^ (((int)u >> 31) | 0x80000000u); return (k & ~127u) | (unsigned)(127 - n); }
__device__ __forceinline__ float key_val(unsigned k) { k &= ~127u; const unsigned u = (k & 0x80000000u) ? (k ^ 0x80000000u) : ~k; return __builtin_bit_cast(float, u); }
__device__ __forceinline__ int key_idx(unsigned k) { return 127 - (int)(k & 127u); }
__device__ __forceinline__ float gelu_erf(float x) { return 0.5f * x * (1.f + erff(x * 0.70710678118654752f)); }

constexpr int PE_TOK = 64;
constexpr int PE_ID = 0, PE_G = 32768;
__device__ __forceinline__ void phase_topk(unsigned char* ws, unsigned char* lds, int tid, int lane, int wave) {
    const float* ST = (const float*)(ws + WS_ST); f32x2v* IDG = (f32x2v*)(ws + WS_IDG);
    int* idL = (int*)(lds + PE_ID); float* gL = (float*)(lds + PE_G);
    for (int tile = blockIdx.x; tile < MTOK / PE_TOK; tile += gridDim.x) {
        const int tok0 = tile * PE_TOK;
        {
            unsigned tk[2][16];
#pragma unroll
            for (int p = 0; p < 2; ++p) {
#pragma unroll
                for (int i = 0; i < 16; ++i) tk[p][i] = 0u;
                const float* sp = ST + (size_t)(wave * 256 + p * 128) * MTOK + tok0 + lane;
#pragma unroll 8
                for (int n = 0; n < 128; ++n) {
                    unsigned v = key_enc(sp[(size_t)n * MTOK], n);
#pragma unroll
                    for (int i = 0; i < 16; ++i) { const unsigned hi_ = max(tk[p][i], v); v = min(tk[p][i], v); tk[p][i] = hi_; }
                }
            }
            float bv[16]; int bi[16];
#pragma unroll
            for (int i = 0; i < 16; ++i) { bv[i] = -INFINITY; bi[i] = 0; }
#pragma unroll
            for (int i = 0; i < 16; ++i)
#pragma unroll
                for (int j = 0; j < 16; ++j) if ((i + 1) * (j + 1) <= 16) {
                    float v = key_val(tk[0][i]) + key_val(tk[1][j]); int id = key_idx(tk[0][i]) * 128 + key_idx(tk[1][j]);
#pragma unroll
                    for (int k = 0; k < 16; ++k) { const bool c = v > bv[k]; const float nv = c ? bv[k] : v; const int ni = c ? bi[k] : id; bv[k] = c ? v : bv[k]; bi[k] = c ? id : bi[k]; v = nv; id = ni; }
                }
            float sum = 0.f; const float bmax = bv[0];
#pragma unroll
            for (int k = 0; k < 16; ++k) { bv[k] = __expf(bv[k] - bmax); sum += bv[k]; }
            const float rinv = 1.f / sum;
#pragma unroll
            for (int k = 0; k < 16; ++k) { idL[(wave * 16 + k) * 64 + lane] = bi[k]; gL[(wave * 16 + k) * 64 + lane] = bv[k] * rinv; }
        }
        __syncthreads();
#pragma unroll
        for (int i = 0; i < 8; ++i) { const int tl = wave * 8 + i;
#pragma unroll
            for (int hf = 0; hf < 2; ++hf) { const int e = lane + 64 * hf; f32x2v pr; pr.x = __builtin_bit_cast(float, idL[e * 64 + tl]); pr.y = gL[e * 64 + tl]; IDG[(size_t)(tok0 + tl) * 128 + e] = pr; } }
        __syncthreads();
    }
}

__device__ __forceinline__ float wave_sum_u(float v) {
    v += __builtin_bit_cast(float, __builtin_amdgcn_update_dpp(0, __builtin_bit_cast(int, v), 0xB1, 0xf, 0xf, false));
    v += __builtin_bit_cast(float, __builtin_amdgcn_update_dpp(0, __builtin_bit_cast(int, v), 0x4E, 0xf, 0xf, false));
    v += __builtin_bit_cast(float, __builtin_amdgcn_update_dpp(0, __builtin_bit_cast(int, v), 0x141, 0xf, 0xf, false));
    v += __builtin_bit_cast(float, __builtin_amdgcn_update_dpp(0, __builtin_bit_cast(int, v), 0x140, 0xf, 0xf, false));
    v += __builtin_bit_cast(float, __builtin_amdgcn_update_dpp(0, __builtin_bit_cast(int, v), 0x142, 0xa, 0xf, false));
    v += __builtin_bit_cast(float, __builtin_amdgcn_update_dpp(0, __builtin_bit_cast(int, v), 0x143, 0xc, 0xf, false));
    return __builtin_bit_cast(float, __builtin_amdgcn_readlane(__builtin_bit_cast(int, v), 63));
}
struct SliceMap { int n_x, rank; unsigned own; };
__device__ __forceinline__ SliceMap slice_setup(unsigned* bar, unsigned x, volatile LAS unsigned* st, int tid, bool census) {
    if (census) {
        if (tid == 0) {
            unsigned np = 0, mi = 0, mine = 1;
#pragma unroll
            for (unsigned j = 0; j < 16; ++j) { const unsigned c = xb_ld(&bar[XB_XCNT(j)]); if (c > 0u) { if (j == x) { mi = np; mine = c; } ++np; } }
            if (np == 0u) np = 1u;
            unsigned mask = 0u;
#pragma unroll
            for (unsigned sl = 0; sl < 8; ++sl) if (sl % np == mi) mask |= 1u << sl;
            st[3] = mine; st[4] = mask;
        }
        __syncthreads();
        SliceMap m; m.n_x = (int)st[3]; m.rank = (int)st[2]; m.own = st[4]; return m;
    } else { SliceMap m; m.n_x = gridDim.x / 8; m.rank = blockIdx.x >> 3; m.own = 1u << (blockIdx.x & 7); return m; }
}
__device__ __forceinline__ f32x2v fp8x2(unsigned w, bool hi) { return hi ? __builtin_amdgcn_cvt_pk_f32_fp8((int)w, true) : __builtin_amdgcn_cvt_pk_f32_fp8((int)w, false); }

__device__ __forceinline__ float sum8_dpp(float v) {
    v += __builtin_bit_cast(float, __builtin_amdgcn_update_dpp(0, __builtin_bit_cast(int, v), 0xB1, 0xf, 0xf, false));
    v += __builtin_bit_cast(float, __builtin_amdgcn_update_dpp(0, __builtin_bit_cast(int, v), 0x4E, 0xf, 0xf, false));
    v += __builtin_bit_cast(float, __builtin_amdgcn_update_dpp(0, __builtin_bit_cast(int, v), 0x141, 0xf, 0xf, false));
    return v;
}
__device__ __forceinline__ void phase_down(unsigned char* ws, const SliceMap sm, int lane, int wave) {
    const unsigned* IDX = (const unsigned*)(ws + WS_IDG); const unsigned char* TDN = ws + WS_TDN; const bf16* H2 = (const bf16*)(ws + WS_H2); float* P = (float*)(ws + WS_P);
    const int gwx = sm.rank * NWAVES + wave, nwx = sm.n_x * NWAVES;
    const int eg = lane >> 3, cs = lane & 7;
#define DN_IDS(t_) do { _Pragma("unroll") for (int i = 0; i < 16; ++i) idn[i] = IDX[((size_t)(t_) * 128 + 8 * i + eg) * 2]; } while (0)
#define DN_ROWS(q_) do { _Pragma("unroll") for (int i = 0; i < 16; ++i) q_[i] = *(const v4u*)(tb + (size_t)idn[i] * 128); } while (0)
#define DN_H(h_, t_) do { const v4u* hp_ = (const v4u*)(H2 + (size_t)(t_) * DM + 128 * s + 16 * cs); h_[0] = hp_[0]; h_[1] = hp_[1]; } while (0)
#define DN_COMPUTE(q_, h_, t_) do { \
        f32x2v hx[8]; \
        hx[0] = (f32x2v){bf_lo(h_[0].x), bf_hi(h_[0].x)}; hx[1] = (f32x2v){bf_lo(h_[0].y), bf_hi(h_[0].y)}; hx[2] = (f32x2v){bf_lo(h_[0].z), bf_hi(h_[0].z)}; hx[3] = (f32x2v){bf_lo(h_[0].w), bf_hi(h_[0].w)}; \
        hx[4] = (f32x2v){bf_lo(h_[1].x), bf_hi(h_[1].x)}; hx[5] = (f32x2v){bf_lo(h_[1].y), bf_hi(h_[1].y)}; hx[6] = (f32x2v){bf_lo(h_[1].z), bf_hi(h_[1].z)}; hx[7] = (f32x2v){bf_lo(h_[1].w), bf_hi(h_[1].w)}; \
        float r0 = 0.f, r1 = 0.f; \
        _Pragma("unroll") for (int i = 0; i < 16; ++i) { \
            f32x2v a = fp8x2(q_[i].x, false) * hx[0], b2 = fp8x2(q_[i].x, true) * hx[1]; \
            a += fp8x2(q_[i].y, false) * hx[2]; b2 += fp8x2(q_[i].y, true) * hx[3]; \
            a += fp8x2(q_[i].z, false) * hx[4]; b2 += fp8x2(q_[i].z, true) * hx[5]; \
            a += fp8x2(q_[i].w, false) * hx[6]; b2 += fp8x2(q_[i].w, true) * hx[7]; \
            const float tot = sum8_dpp((a[0] + a[1]) + (b2[0] + b2[1])); \
            if (i < 8) r0 = (cs == i) ? tot : r0; else r1 = (cs == i - 8) ? tot : r1; } \
        float* pp = P + ((size_t)s * MTOK + (t_)) * 128 + 8 * cs + eg; pp[0] = r0; pp[64] = r1; } while (0)
    for (int s = 0; s < 8; ++s) {
        if (!((sm.own >> s) & 1u)) continue;
        const unsigned char* tb = TDN + (size_t)s * 16384 * 128 + 16 * cs;
        int t = gwx; if (t >= MTOK) continue;
        unsigned idn[16]; v4u qa[16], ha[2], hb[2];
        DN_IDS(t); DN_H(ha, t);
        for (;;) {
            DN_ROWS(qa);
            const bool hasB = t + nwx < MTOK;
            if (hasB) { DN_IDS(t + nwx); DN_H(hb, t + nwx); }
            DN_COMPUTE(qa, ha, t);
            if (!hasB) break;
            t += nwx;
            DN_ROWS(qa);
            const bool hasA = t + nwx < MTOK;
            if (hasA) { DN_IDS(t + nwx); DN_H(ha, t + nwx); }
            DN_COMPUTE(qa, hb, t);
            if (!hasA) break;
            t += nwx;
        }
    }
#undef DN_IDS
#undef DN_ROWS
#undef DN_H
#undef DN_COMPUTE
}

__device__ __forceinline__ void phase_combine(unsigned char* ws, int lane, int wave) {
    const f32x2v* IDG = (const f32x2v*)(ws + WS_IDG); unsigned* CWI = (unsigned*)(ws + WS_CW); float* CWW = (float*)(ws + WS_CW + 8 * MiB); const float* P = (const float*)(ws + WS_P);
    const float* SDN = (const float*)(ws + WS_SDN); const float* SUP = (const float*)(ws + WS_SUP);
    const int gw = blockIdx.x * NWAVES + wave, NGW = gridDim.x * NWAVES;
    for (int t = gw; t < MTOK; t += NGW) {
#pragma unroll
        for (int hf = 0; hf < 2; ++hf) {
            const int e = lane + 64 * hf;
            const f32x2v pr = IDG[(size_t)t * 128 + e]; const unsigned id = __builtin_bit_cast(unsigned, pr.x);
            float sum = 0.f;
#pragma unroll
            for (int x = 0; x < 8; ++x) sum += P[((size_t)x * MTOK + t) * 128 + e];
            const float c = pr.y * gelu_erf(sum * SDN[id]) * SUP[id];
            CWI[(size_t)t * 128 + e] = id; CWW[(size_t)t * 128 + e] = c;
        }
    }
}

__device__ __forceinline__ void phase_up(unsigned char* ws, const SliceMap sm, int lane, int wave, int sub) {
    const unsigned* CWI = (const unsigned*)(ws + WS_CW); const float* CWW = (const float*)(ws + WS_CW + 8 * MiB); const unsigned char* TUP = ws + WS_TUP; float* F = (float*)(ws + WS_F);
    const int gwx = sm.rank * NWAVES + wave, nwx = sm.n_x * NWAVES;
    const int eg = lane >> 3, cs = lane & 7;
#define UP_IDS(t_) do { _Pragma("unroll") for (int i = 0; i < 16; ++i) idn[i] = CWI[(size_t)(t_) * 128 + 8 * i + eg]; } while (0)
#define UP_W(w_, t_) do { _Pragma("unroll") for (int i = 0; i < 16; ++i) w_[i] = CWW[(size_t)(t_) * 128 + 8 * i + eg]; } while (0)
#define UP_ROWS(q_) do { _Pragma("unroll") for (int i = 0; i < 16; ++i) q_[i] = *(const v4u*)(tb + (size_t)idn[i] * 128); } while (0)
#define UP_COMPUTE(q_, w_, t_) do { \
        f32x2v acc[8]; \
        _Pragma("unroll") for (int k = 0; k < 8; ++k) acc[k] = (f32x2v){0.f, 0.f}; \
        if (sub == 1) { unsigned xx = 0u; _Pragma("unroll") for (int i = 0; i < 16; ++i) xx ^= q_[i].x ^ q_[i].y ^ q_[i].z ^ q_[i].w ^ __builtin_bit_cast(unsigned, w_[i]); acc[0][0] = __builtin_bit_cast(float, xx); } else \
        _Pragma("unroll") for (int i = 0; i < 16; ++i) { const float w = w_[i]; \
            acc[0] += fp8x2(q_[i].x, false) * w; acc[1] += fp8x2(q_[i].x, true) * w; acc[2] += fp8x2(q_[i].y, false) * w; acc[3] += fp8x2(q_[i].y, true) * w; \
            acc[4] += fp8x2(q_[i].z, false) * w; acc[5] += fp8x2(q_[i].z, true) * w; acc[6] += fp8x2(q_[i].w, false) * w; acc[7] += fp8x2(q_[i].w, true) * w; } \
        _Pragma("unroll") for (int k = 0; k < 8; ++k) \
            _Pragma("unroll") for (int c = 0; c < 2; ++c) { float v = acc[k][c]; v += __shfl_xor(v, 8); v += __shfl_xor(v, 16); v += __shfl_xor(v, 32); acc[k][c] = v; } \
        if (eg == 0) { float* fp = F + (size_t)(t_) * DM + 128 * s + 16 * cs; \
            _Pragma("unroll") for (int k = 0; k < 4; ++k) *(f32x4*)(fp + 4 * k) = (f32x4){acc[2 * k][0], acc[2 * k][1], acc[2 * k + 1][0], acc[2 * k + 1][1]}; } } while (0)
    for (int s = 0; s < 8; ++s) {
        if (!((sm.own >> s) & 1u)) continue;
        const unsigned char* tb = TUP + (size_t)s * 16384 * 128 + 16 * cs;
        int t = gwx; if (t >= MTOK) continue;
        unsigned idn[16]; float wa[16], wb[16]; v4u qa[16];
        UP_IDS(t); UP_W(wa, t);
        for (;;) {
            UP_ROWS(qa);
            const bool hasB = t + nwx < MTOK;
            if (hasB) { UP_IDS(t + nwx); UP_W(wb, t + nwx); }
            UP_COMPUTE(qa, wa, t);
            if (!hasB) break;
            t += nwx;
            UP_ROWS(qa);
            const bool hasA = t + nwx < MTOK;
            if (hasA) { UP_IDS(t + nwx); UP_W(wa, t + nwx); }
            UP_COMPUTE(qa, wb, t);
            if (!hasA) break;
            t += nwx;
        }
    }
#undef UP_IDS
#undef UP_W
#undef UP_ROWS
#undef UP_COMPUTE
}

__device__ __forceinline__ void phase_final(const float* const* in, unsigned char* ws, float* OUT, int lane, int wave) {
    const float pscale = (PROBE_TIME_PHASE >= 0) ? 1.f + sqrtf((float)__hip_atomic_load((const unsigned*)(ws + WS_CTL) + CW_TIME, __ATOMIC_RELAXED, __HIP_MEMORY_SCOPE_AGENT) * 1e-7f) : 1.f;
    const float* F = (const float*)(ws + WS_F); const float* mod = (const float*)(ws + WS_MOD); const float* g2 = in[19]; const float* b2 = in[20];
    const int gw = blockIdx.x * NWAVES + wave, NGW = gridDim.x * NWAVES;
    if (gw >= MTOK) return;
    f32x4 xv[4], fv[4], xn[4], fn[4];
    { const f32x4* xr = (const f32x4*)(OUT + (size_t)gw * DM) + lane; const f32x4* fr = (const f32x4*)(F + (size_t)gw * DM) + lane;
#pragma unroll
      for (int j = 0; j < 4; ++j) { xv[j] = xr[64 * j]; fv[j] = fr[64 * j]; } }
    for (int m = gw; m < MTOK; m += NGW) {
        if (m + NGW < MTOK) { const f32x4* xr = (const f32x4*)(OUT + (size_t)(m + NGW) * DM) + lane; const f32x4* fr = (const f32x4*)(F + (size_t)(m + NGW) * DM) + lane;
#pragma unroll
            for (int j = 0; j < 4; ++j) { xn[j] = xr[64 * j]; fn[j] = fr[64 * j]; } }
        const int b = m >> 11; const float* gf = mod + b * MODS + 5 * DM;
        f32x4* xo = (f32x4*)(OUT + (size_t)m * DM) + lane;
        f32x4 v[4];
#pragma unroll
        for (int j = 0; j < 4; ++j) { const f32x4 gg = *((const f32x4*)gf + lane + 64 * j); v[j] = xv[j] * DN_ALPHA + (gg + 1.0f) * fv[j]; }
        const RowStats st = row_stats(v);
#pragma unroll
        for (int j = 0; j < 4; ++j) { const f32x4 gg = *((const f32x4*)g2 + lane + 64 * j), bb = *((const f32x4*)b2 + lane + 64 * j); xo[64 * j] = ((v[j] - st.mean) * st.rstd * gg + bb) * pscale; }
#pragma unroll
        for (int j = 0; j < 4; ++j) { xv[j] = xn[j]; fv[j] = fn[j]; }
    }
}

struct Args { const float* in[21]; float* out; unsigned char* ws; int ph_lo, ph_hi, sub, pad; };
__global__ void __launch_bounds__(NWAVES * 64, 2) fwd_kernel(Args args) {
    extern __shared__ __attribute__((aligned(16))) unsigned char lds[];
    LAS unsigned char* ldsl = (LAS unsigned char*)lds;
    const int tid = threadIdx.x, lane = tid & 63, wave = __builtin_amdgcn_readfirstlane(tid >> 6);
    const int G = gridDim.x;
    unsigned char* ws = args.ws;
    gu32* ctl = (gu32*)(ws + WS_CTL);
    for (int u = tid; u < (LDS_BYTES - LDSCTL_OFF) / 4; u += NWAVES * 64) ((LAS unsigned*)(ldsl + LDSCTL_OFF))[u] = 0u;
    __syncthreads();
    XcdBarrier bar; bar.bar = (unsigned*)(ctl + CW_BAR); bar.x = 0; bar.st = nullptr;
    volatile LAS unsigned* bst = (volatile LAS unsigned*)(ldsl + MISC_OFF) + 8;
    if (N_LAUNCHES == 1) { bar.bar = (unsigned*)(ctl + CW_BAR); bar.x = xb_xcc_id(); bar.st = bst; if (tid == 0) bst[2] = xb_add(&bar.bar[XB_XCNT(bar.x)], 1u); }
    const int lo = args.ph_lo, hi = args.ph_hi;
#define IN(k) (lo <= (k) && (k) < hi)
    unsigned long long tprobe0 = 0ull;
#define SEAM(k) do { if (IN(k) && IN((k) + 1)) xcd_barrier(bar); \
        if (PROBE_TIME_PHASE == (k) && blockIdx.x == 0 && tid == 0) __hip_atomic_store((unsigned*)(ctl + CW_TIME), (unsigned)(rt() - tprobe0), __ATOMIC_RELAXED, __HIP_MEMORY_SCOPE_AGENT); \
        if (PROBE_TIME_PHASE == (k) + 1 && blockIdx.x == 0 && tid == 0) tprobe0 = rt(); } while (0)
    if (PROBE_TIME_PHASE == 0 && blockIdx.x == 0 && tid == 0) tprobe0 = rt();

    if (IN(0)) { phase_mod(args.in[1], args.in[2], args.in[3], (float*)(ws + WS_MOD), lds, tid, lane, wave); }
    SEAM(0);
    if (IN(1)) { phase_prologue(args.in, ws, ldsl, lane, wave); }
    SEAM(1);
    if (IN(2)) {
        { pg8::Gemm g{(const bf16*)(ws + WS_XN), (const bf16*)(ws + WS_WQK), MTOK, 2048, DM}; pg8::StaticOrder S; S.init(MTOK, 2048, G, (int)blockIdx.x);
          pg8::EpiBf16 E{(bf16*)(ws + WS_QK), QKP};
          pg8::gemm_phase<pg8::EpiBf16, pg8::StaticOrder, true, true>(ldsl, g, S, E); }
        __syncthreads();
        { pg8::Gemm g{(const bf16*)(ws + WS_WV), (const bf16*)(ws + WS_XN), 1024, MTOK, DM}; pg8::StaticOrder S; S.init(1024, MTOK, G, (int)blockIdx.x);
          pg8::EpiBf16 E{(bf16*)(ws + WS_VT), VTP};
          pg8::gemm_phase<pg8::EpiBf16, pg8::StaticOrder, true, true>(ldsl, g, S, E); }
    }
    SEAM(2);
    if (IN(3)) { __syncthreads(); phase_attention(args.in, ws, lds, tid, lane, wave, args.sub); }
    SEAM(3);
    if (IN(4)) {
        pg8::Gemm g{(const bf16*)(ws + WS_CC), (const bf16*)(ws + WS_WO), MTOK, DM, DM}; pg8::StaticOrder S; S.init(MTOK, DM, G, (int)blockIdx.x);
        pg8::EpiY E{args.in[0], (const float*)(ws + WS_MOD) + 2 * DM, MODS, (float*)(ws + WS_Y), DN_ALPHA};
        pg8::gemm_phase<pg8::EpiY, pg8::StaticOrder, true, true>(ldsl, g, S, E);
    }
    SEAM(4);
    if (IN(5)) { phase_rows(args.in, ws, args.out, lane, wave); }
    SEAM(5);
    if (IN(6)) {
        pg8::Gemm g{(const bf16*)(ws + WS_WC), (const bf16*)(ws + WS_H2), 2048, MTOK, DM}; pg8::StaticOrder S; S.init(2048, MTOK, G, (int)blockIdx.x);
        pg8::EpiF32 E{(float*)(ws + WS_ST), MTOK};
        pg8::gemm_phase<pg8::EpiF32, pg8::StaticOrder, true, true>(ldsl, g, S, E);
    }
    SEAM(6);
    if (IN(7)) { __syncthreads(); phase_topk(ws, lds, tid, lane, wave); }
    SEAM(7);
    if (IN(8)) { const SliceMap sm = slice_setup((unsigned*)(ctl + CW_BAR), bar.x, bst, tid, N_LAUNCHES == 1 && lo == 0 && hi == N_PHASES); phase_down(ws, sm, lane, wave); }
    SEAM(8);
    if (IN(9)) { phase_combine(ws, lane, wave); }
    SEAM(9);
    if (IN(10)) { const SliceMap sm = slice_setup((unsigned*)(ctl + CW_BAR), bar.x, bst, tid, N_LAUNCHES == 1 && lo == 0 && hi == N_PHASES); phase_up(ws, sm, lane, wave, args.sub); }
    SEAM(10);
    if (IN(11)) { phase_final(args.in, ws, args.out, lane, wave); }
#undef IN
#undef SEAM
}

extern "C" void kernel_launch(void* const* d_in, const int* in_sizes, int n_in, void* d_out, int out_size, void* d_ws, size_t ws_size, hipStream_t stream) {
    static int grid = 0;
    if (grid == 0) {
        if (n_in != 21 || out_size != MTOK * DM || ws_size < WS_END) { fprintf(stderr, "kernel_launch: unexpected shapes (n_in %d out %d ws %zu)\n", n_in, out_size, ws_size); grid = -1; return; }
        int dev = 0, cus = 0, per_cu = 0;
        if (hipGetDevice(&dev) != hipSuccess || hipDeviceGetAttribute(&cus, hipDeviceAttributeMultiprocessorCount, dev) != hipSuccess) { grid = -1; return; }
        if (hipFuncSetAttribute((const void*)fwd_kernel, hipFuncAttributeMaxDynamicSharedMemorySize, LDS_BYTES) != hipSuccess) { fprintf(stderr, "kernel_launch: hipFuncSetAttribute failed\n"); grid = -1; return; }
        if (hipOccupancyMaxActiveBlocksPerMultiprocessor(&per_cu, (const void*)fwd_kernel, NWAVES * 64, LDS_BYTES) != hipSuccess || per_cu < 1) { fprintf(stderr, "kernel_launch: occupancy query says %d\n", per_cu); }
        (void)hipGetLastError();
        grid = cus;
    }
    if (grid < 0) return;
    if (hipMemsetAsync((char*)d_ws + WS_CTL, 0, CTL_ZERO_BYTES, stream) != hipSuccess) return;
    Args a{};
    for (int i = 0; i < 21; ++i) a.in[i] = (const float*)d_in[i];
    a.out = (float*)d_out; a.ws = (unsigned char*)d_ws; a.sub = 3;
    if (N_LAUNCHES == 1) { a.ph_lo = 0; a.ph_hi = N_PHASES; hipLaunchKernelGGL(fwd_kernel, dim3(grid), dim3(NWAVES * 64), LDS_BYTES, stream, a); }
    else { for (int p = 0; p < N_PHASES; ++p) { a.ph_lo = p; a.ph_hi = p + 1; hipLaunchKernelGGL(fwd_kernel, dim3(grid), dim3(NWAVES * 64), LDS_BYTES, stream, a); } }
    if (PROBE_EXTRA_MASK) { for (int p = 0; p < N_PHASES; ++p) if ((PROBE_EXTRA_MASK >> p) & 1) { a.ph_lo = p; a.ph_hi = p + 1; a.sub = PROBE_SUB; hipLaunchKernelGGL(fwd_kernel, dim3(grid), dim3(NWAVES * 64), LDS_BYTES, stream, a); } }
}
```

```cpp
#include <hip/hip_runtime.h>
#include <hip/hip_bf16.h>
#include <cstdio>
#include <cstdint>
#include <cmath>
namespace pg8 {
#define PG8_LAS __attribute__((address_space(3)))
typedef unsigned short bf16_t;
typedef short bf16x8 __attribute__((ext_vector_type(8)));
typedef float f32x4 __attribute__((ext_vector_type(4)));
typedef unsigned u32x4 __attribute__((ext_vector_type(4)));
constexpr int BM = 256, BK = 64, HALF = 128, HTB = HALF * BK * 2  , STAGE_BYTES = 8 * HTB, NXCD = 8, WGM = 8;

__host__ __device__ __forceinline__ int lds_byte(int r, int c) { const int st = (r >> 4) * 2 + (c >> 5), rr = r & 15, cc = c & 31, ob = rr * 64 + cc * 2; return st * 1024 + (ob ^ (((ob >> 9) & 1) << 5)); }
__host__ __device__ __forceinline__ void stage_rc(int b, int& R, int& C) { const int st = b / 1024, sb = b % 1024, swz = sb ^ (((sb >> 9) & 1) << 5); R = (st >> 1) * 16 + swz / 64; C = (st & 1) * 32 + (swz % 64) / 2; }
__host__ __device__ __forceinline__ int perm32(int rho) { const int n = rho >> 4, i = rho & 15; return 8 * (i >> 2) + 4 * n + (i & 3); }

struct Unit { int pm, pn; };
struct Gemm { const bf16_t* A; const bf16_t* Bt; int M, N, K; };

struct StaticOrder {
    int nM, nN, nwg, G, c;
    __host__ __device__ void init(int M, int N, int G_, int c_) { nM = M / BM; nN = N / BM; nwg = nM * nN; G = G_; c = c_; }
    __host__ __device__ bool next(int i, Unit& u) const {
        const long L = (long)i * G + c; if (L >= nwg) return false;
        int wgid = (int)L; { const int q = nwg / NXCD, r = nwg % NXCD, xcd = wgid % NXCD, off = wgid / NXCD; wgid = (xcd < r ? xcd * (q + 1) : r * (q + 1) + (xcd - r) * q) + off; }
        const int nig = WGM * nN, gid = wgid / nig, fm = gid * WGM, gsz = (nM - fm) < WGM ? (nM - fm) : WGM;
        u.pm = fm + ((wgid % nig) % gsz); u.pn = (wgid % nig) / gsz; return true;
    }
    __device__ __forceinline__ void a_ready(const Unit&) const {}
    __device__ __forceinline__ void done(const Unit&) const {}
};

__device__ __forceinline__ unsigned cvt_pk_bf16(float lo, float hi) { unsigned r; asm volatile("v_cvt_pk_bf16_f32 %0, %1, %2" : "=v"(r) : "v"(lo), "v"(hi)); return r; }
typedef float f32x2 __attribute__((ext_vector_type(2)));
struct EpiBf16 {
    static constexpr bool PERM = true, AFTER_DRAIN = false;
    bf16_t* O; int ldc;
    __device__ __forceinline__ void operator()(const f32x4 (&acc)[2][2][4][2], const Unit& u, int wr, int wc, int fr, int fq) const {
        const int row0 = u.pm * BM + wr * 64 + fr; const int col0 = u.pn * BM + wc * 32 + 8 * fq;
#pragma unroll
        for (int ai = 0; ai < 2; ++ai)
#pragma unroll
            for (int m = 0; m < 4; ++m) { bf16_t* rowp = O + (size_t)(row0 + ai * HALF + m * 16) * ldc + col0;
#pragma unroll
                for (int bj = 0; bj < 2; ++bj) { const f32x4 v0 = acc[ai][bj][m][0], v1 = acc[ai][bj][m][1];
                    u32x4 w; w.x = cvt_pk_bf16(v0[0], v0[1]); w.y = cvt_pk_bf16(v0[2], v0[3]); w.z = cvt_pk_bf16(v1[0], v1[1]); w.w = cvt_pk_bf16(v1[2], v1[3]);
                    *(u32x4*)(rowp + bj * HALF) = w; } }
    }
};
struct EpiF32 {
    static constexpr bool PERM = false, AFTER_DRAIN = false;
    float* O; int ldc;
    __device__ __forceinline__ void operator()(const f32x4 (&acc)[2][2][4][2], const Unit& u, int wr, int wc, int fr, int fq) const {
        const int row0 = u.pm * BM + wr * 64 + fr; const int col0 = u.pn * BM + wc * 32 + 4 * fq;
#pragma unroll
        for (int ai = 0; ai < 2; ++ai)
#pragma unroll
            for (int m = 0; m < 4; ++m) { float* rowp = O + (size_t)(row0 + ai * HALF + m * 16) * ldc + col0;
#pragma unroll
                for (int bj = 0; bj < 2; ++bj)
#pragma unroll
                    for (int n = 0; n < 2; ++n) *(f32x4*)(rowp + bj * HALF + n * 16) = acc[ai][bj][m][n]; }
    }
};
struct EpiF16 {
    static constexpr bool PERM = true, AFTER_DRAIN = false;
    _Float16* O; int ldc;
    __device__ __forceinline__ void operator()(const f32x4 (&acc)[2][2][4][2], const Unit& u, int wr, int wc, int fr, int fq) const {
        typedef _Float16 h2 __attribute__((ext_vector_type(2)));
        const int row0 = u.pm * BM + wr * 64 + fr; const int col0 = u.pn * BM + wc * 32 + 8 * fq;
#pragma unroll
        for (int ai = 0; ai < 2; ++ai)
#pragma unroll
            for (int m = 0; m < 4; ++m) { _Float16* rowp = O + (size_t)(row0 + ai * HALF + m * 16) * ldc + col0;
#pragma unroll
                for (int bj = 0; bj < 2; ++bj) { const f32x4 v0 = acc[ai][bj][m][0], v1 = acc[ai][bj][m][1];
                    const h2 a = {(_Float16)v0[0], (_Float16)v0[1]}, b = {(_Float16)v0[2], (_Float16)v0[3]}, c = {(_Float16)v1[0], (_Float16)v1[1]}, d = {(_Float16)v1[2], (_Float16)v1[3]};
                    u32x4 w; w.x = __builtin_bit_cast(unsigned, a); w.y = __builtin_bit_cast(unsigned, b); w.z = __builtin_bit_cast(unsigned, c); w.w = __builtin_bit_cast(unsigned, d);
                    *(u32x4*)(rowp + bj * HALF) = w; } }
    }
};
struct EpiY {
    static constexpr bool PERM = false, AFTER_DRAIN = false;
    const float* X; const float* gate;   int gstride; float* Y; float alpha;
    __device__ __forceinline__ void operator()(const f32x4 (&acc)[2][2][4][2], const Unit& u, int wr, int wc, int fr, int fq) const {
        const int row0 = u.pm * BM + wr * 64 + fr; const int col0 = u.pn * BM + wc * 32 + 4 * fq;
        const float* gp = gate + (size_t)((u.pm * BM) >> 11) * gstride + col0;
        f32x4 gv[2][2];
#pragma unroll
        for (int bj = 0; bj < 2; ++bj)
#pragma unroll
            for (int n = 0; n < 2; ++n) gv[bj][n] = *(const f32x4*)(gp + bj * HALF + n * 16) + 1.0f;
#pragma unroll
        for (int ai = 0; ai < 2; ++ai)
#pragma unroll
            for (int m = 0; m < 4; ++m) { const size_t off = (size_t)(row0 + ai * HALF + m * 16) * 1024 + col0;
#pragma unroll
                for (int bj = 0; bj < 2; ++bj)
#pragma unroll
                    for (int n = 0; n < 2; ++n) { const f32x4 xv = *(const f32x4*)(X + off + bj * HALF + n * 16);
                        *(f32x4*)(Y + off + bj * HALF + n * 16) = xv * alpha + gv[bj][n] * acc[ai][bj][m][n]; } }
    }
};

template <class Epi, class Sched, bool ALIGN_EPI = false, bool SP2 = false>
__device__ __forceinline__ void gemm_phase(PG8_LAS unsigned char* lds, const Gemm g, const Sched& S, const Epi& E) {
    const int tid = threadIdx.x, wid = __builtin_amdgcn_readfirstlane(tid >> 6), lane = tid & 63, wr = wid >> 2, wc = wid & 3, fr = lane & 15, fq = lane >> 4;
    const int K = g.K, nt = K / BK;
    unsigned voffA[2], voffB[2];
#pragma unroll
    for (int i = 0; i < 2; ++i) { int R, C; stage_rc(tid * 16 + i * 8192, R, C); const int Rb = Epi::PERM ? ((R & ~31) + perm32(R & 31)) : R;
        voffA[i] = (unsigned)(R * K + C) * 2u; voffB[i] = (unsigned)(Rb * K + C) * 2u; }
    const size_t kstep = (size_t)(BK * 2);
    const size_t hstep = (size_t)HALF * K * 2;
    const size_t tstep = 2 * hstep;
    const unsigned ldsw = (unsigned)wid * 1024u;
    const int aoff = lds_byte(wr * 64 + fr, fq * 8), boff = lds_byte(wc * 32 + fr, fq * 8);
#define PG8_SA(b, h) (((b) * 2 + (h)) * HTB)
#define PG8_SB(b, h) ((4 + (b) * 2 + (h)) * HTB)
#define PG8_STAGE(bufoff, gbase, voff) do { _Pragma("unroll") for (int _i = 0; _i < 2; ++_i) \
        __builtin_amdgcn_global_load_lds((const unsigned*)((const char*)(gbase) + (voff)[_i]), (PG8_LAS unsigned*)(lds + (bufoff) + ldsw + _i * 8192), 16, 0, 0); } while (0)
#define PG8_LDA(dst, b, h) do { _Pragma("unroll") for (int m = 0; m < 4; ++m) _Pragma("unroll") for (int k = 0; k < 2; ++k) dst[m][k] = *(const PG8_LAS bf16x8*)(lds + PG8_SA(b, h) + aoff + m * 2048 + k * 1024); } while (0)
#define PG8_LDB(dst, b, h) do { _Pragma("unroll") for (int n = 0; n < 2; ++n) _Pragma("unroll") for (int k = 0; k < 2; ++k) dst[n][k] = *(const PG8_LAS bf16x8*)(lds + PG8_SB(b, h) + boff + n * 2048 + k * 1024); } while (0)
#define PG8_MMA(ai, bj, At, Bt) do { __builtin_amdgcn_s_setprio(1); _Pragma("unroll") for (int m = 0; m < 4; ++m) _Pragma("unroll") for (int n = 0; n < 2; ++n) _Pragma("unroll") for (int k = 0; k < 2; ++k) \
        acc[ai][bj][m][n] = __builtin_amdgcn_mfma_f32_16x16x32_bf16(Bt[n][k], At[m][k], acc[ai][bj][m][n], 0, 0, 0); __builtin_amdgcn_s_setprio(0); } while (0)
#define PG8_WAIT_V(n) asm volatile("s_waitcnt vmcnt(" #n ")" ::: "memory")
#define PG8_WAIT_L(n) asm volatile("s_waitcnt lgkmcnt(" #n ")" ::: "memory")
#define PG8_BAR __builtin_amdgcn_s_barrier()
#define PG8_SCHED __builtin_amdgcn_sched_barrier(0)
    Unit cur, nxt; int ui = 0;
    if (!S.next(0, cur)) return;
    f32x4 acc[2][2][4][2];
#pragma unroll
    for (int a = 0; a < 2; ++a)
#pragma unroll
        for (int b = 0; b < 2; ++b)
#pragma unroll
            for (int m = 0; m < 4; ++m)
#pragma unroll
                for (int n = 0; n < 2; ++n) acc[a][b][m][n] = (f32x4){0.f, 0.f, 0.f, 0.f};
    bf16x8 At[4][2], B0[2][2], B1[2][2];
    const char* cA = (const char*)g.A + (size_t)cur.pm * tstep; const char* cB = (const char*)g.Bt + (size_t)cur.pn * tstep;
    S.a_ready(cur);
    if constexpr (SP2) {
        PG8_STAGE(PG8_SB(0, 0), cB, voffB); PG8_STAGE(PG8_SB(0, 1), cB + hstep, voffB); PG8_STAGE(PG8_SA(0, 0), cA, voffA); PG8_STAGE(PG8_SA(0, 1), cA + hstep, voffA);
        if (wr == 1) PG8_BAR;
        PG8_WAIT_V(2); PG8_BAR;
        PG8_STAGE(PG8_SB(1, 0), cB + kstep, voffB); PG8_STAGE(PG8_SA(1, 0), cA + kstep, voffA); PG8_STAGE(PG8_SB(1, 1), cB + hstep + kstep, voffB);
        PG8_WAIT_V(6); PG8_BAR;
    } else {
        PG8_STAGE(PG8_SB(0, 0), cB, voffB); PG8_STAGE(PG8_SA(0, 0), cA, voffA); PG8_STAGE(PG8_SB(0, 1), cB + hstep, voffB); PG8_STAGE(PG8_SA(0, 1), cA + hstep, voffA);
        if (wr == 1) PG8_BAR;
        PG8_WAIT_V(4); PG8_BAR;
        PG8_STAGE(PG8_SB(1, 0), cB + kstep, voffB); PG8_STAGE(PG8_SA(1, 0), cA + kstep, voffA); PG8_STAGE(PG8_SB(1, 1), cB + hstep + kstep, voffB);
        PG8_WAIT_V(6); PG8_BAR;
    }
    for (;;) {
        const bool has_next = S.next(ui + 1, nxt);
        const char* nA = has_next ? (const char*)g.A + (size_t)nxt.pm * tstep : cA; const char* nB = has_next ? (const char*)g.Bt + (size_t)nxt.pn * tstep : cB;
        for (int t = 0; t < nt; t += 2) {
            const bool last = (t == nt - 2);
            const char* a1 = cA + (size_t)(t + 1) * kstep;
            const char* a2 = last ? nA : cA + (size_t)(t + 2) * kstep; const char* b2 = last ? nB : cB + (size_t)(t + 2) * kstep;
            const char* a3 = a2 + kstep; const char* b3 = b2 + kstep;
            if (last && has_next) S.a_ready(nxt);
            if constexpr (SP2) {
            PG8_LDB(B0, 0, 0); PG8_LDB(B1, 0, 1); PG8_SCHED; PG8_LDA(At, 0, 0); PG8_STAGE(PG8_SA(1, 1), a1 + hstep, voffA);
            PG8_WAIT_V(8); PG8_WAIT_L(0); PG8_BAR; PG8_MMA(0, 0, At, B0); PG8_MMA(0, 1, At, B1); PG8_BAR; PG8_SCHED;
            PG8_LDA(At, 0, 1); PG8_STAGE(PG8_SB(0, 0), b2, voffB); PG8_STAGE(PG8_SB(0, 1), b2 + hstep, voffB); PG8_STAGE(PG8_SA(0, 0), a2, voffA);
            PG8_WAIT_V(8); PG8_WAIT_L(0); PG8_BAR; PG8_MMA(1, 0, At, B0); PG8_MMA(1, 1, At, B1); PG8_BAR; PG8_SCHED;
            PG8_LDB(B0, 1, 0); PG8_LDB(B1, 1, 1); PG8_SCHED; PG8_LDA(At, 1, 0); PG8_STAGE(PG8_SA(0, 1), a2 + hstep, voffA);
            PG8_WAIT_V(8); PG8_WAIT_L(0); PG8_BAR; PG8_MMA(0, 0, At, B0); PG8_MMA(0, 1, At, B1); PG8_BAR; PG8_SCHED;
            PG8_LDA(At, 1, 1); PG8_STAGE(PG8_SB(1, 0), b3, voffB); PG8_STAGE(PG8_SB(1, 1), b3 + hstep, voffB); PG8_STAGE(PG8_SA(1, 0), a3, voffA);
            PG8_WAIT_V(8); PG8_WAIT_L(0); PG8_BAR; PG8_MMA(1, 0, At, B0); PG8_MMA(1, 1, At, B1); PG8_BAR; PG8_SCHED;
            } else {
            PG8_LDB(B0, 0, 0); PG8_SCHED; PG8_LDA(At, 0, 0); PG8_STAGE(PG8_SA(1, 1), a1 + hstep, voffA);
            PG8_WAIT_L(8); PG8_BAR; PG8_WAIT_L(0); PG8_MMA(0, 0, At, B0); PG8_BAR; PG8_SCHED;
            PG8_LDB(B1, 0, 1); PG8_STAGE(PG8_SB(0, 0), b2, voffB);
            PG8_BAR; PG8_WAIT_L(0); PG8_MMA(0, 1, At, B1); PG8_BAR;
            PG8_LDA(At, 0, 1); PG8_STAGE(PG8_SA(0, 0), a2, voffA);
            PG8_BAR; PG8_WAIT_L(0); PG8_MMA(1, 0, At, B0); PG8_BAR; PG8_SCHED;
            PG8_STAGE(PG8_SB(0, 1), b2 + hstep, voffB);
            PG8_WAIT_V(6); PG8_BAR; PG8_MMA(1, 1, At, B1); PG8_BAR;
            PG8_LDB(B0, 1, 0); PG8_SCHED; PG8_LDA(At, 1, 0); PG8_STAGE(PG8_SA(0, 1), a2 + hstep, voffA);
            PG8_WAIT_L(8); PG8_BAR; PG8_WAIT_L(0); PG8_MMA(0, 0, At, B0); PG8_BAR; PG8_SCHED;
            PG8_LDB(B1, 1, 1); PG8_STAGE(PG8_SB(1, 0), b3, voffB);
            PG8_BAR; PG8_WAIT_L(0); PG8_MMA(0, 1, At, B1); PG8_BAR;
            PG8_LDA(At, 1, 1); PG8_STAGE(PG8_SA(1, 0), a3, voffA);
            PG8_BAR; PG8_WAIT_L(0); PG8_MMA(1, 0, At, B0); PG8_BAR; PG8_SCHED;
            PG8_STAGE(PG8_SB(1, 1), b3 + hstep, voffB);
            PG8_WAIT_V(6); PG8_BAR; PG8_MMA(1, 1, At, B1); PG8_BAR;
            }
        }
        if constexpr (ALIGN_EPI) { if (wr == 0) PG8_BAR; }
        if constexpr (!Epi::AFTER_DRAIN) { E(acc, cur, wr, wc, fr, fq); S.done(cur); }
        if (!has_next) break;
#pragma unroll
        for (int a = 0; a < 2; ++a)
#pragma unroll
            for (int b = 0; b < 2; ++b)
#pragma unroll
                for (int m = 0; m < 4; ++m)
#pragma unroll
                    for (int n = 0; n < 2; ++n) acc[a][b][m][n] = (f32x4){0.f, 0.f, 0.f, 0.f};
        cur = nxt; cA = nA; cB = nB; ++ui;
        if constexpr (ALIGN_EPI) { if (wr == 1) PG8_BAR; }
    }
    PG8_WAIT_V(0);
    if constexpr (!ALIGN_EPI) { if (wr == 0) PG8_BAR; }
    PG8_BAR;
    if constexpr (Epi::AFTER_DRAIN) { E.fused(acc, cur, wr, wc, fr, fq, lds, wid, lane); S.done(cur); }
#undef PG8_SA
#undef PG8_SB
#undef PG8_STAGE
#undef PG8_LDA
#undef PG8_LDB
#undef PG8_MMA
#undef PG8_WAIT_V
#undef PG8_WAIT_L
#undef PG8_BAR
#undef PG8_SCHED
}
}
#define GAS __attribute__((address_space(1)))
#define LAS __attribute__((address_space(3)))
typedef unsigned short bf16;
typedef unsigned v4u __attribute__((ext_vector_type(4)));
typedef float f32x4 __attribute__((ext_vector_type(4)));
typedef short bf16x8 __attribute__((ext_vector_type(8)));
typedef GAS unsigned gu32;
typedef GAS unsigned long long gu64;
#define RLX_AGENT __ATOMIC_RELAXED, __HIP_MEMORY_SCOPE_AGENT
#define LDS_WAIT() asm volatile("s_waitcnt lgkmcnt(0)" ::: "memory")
#define VM_WAIT() asm volatile("s_waitcnt vmcnt(0)" ::: "memory")
__device__ __forceinline__ unsigned long long rt() { return __builtin_amdgcn_s_memrealtime(); }
__device__ __forceinline__ unsigned f2bf(float f) { unsigned u = __builtin_bit_cast(unsigned, f); return (u + 0x7fffu + ((u >> 16) & 1u)) >> 16; }
__device__ __forceinline__ unsigned pk2(float lo, float hi) { return f2bf(lo) | (f2bf(hi) << 16); }

#define XB_TMO      128
#define XB_XCNT(j)  (256  + 64 * (j))
#define XB_XSUB(j)  (1280 + 64 * (j))
#define XB_XGEN(j)  (2304 + 64 * (j))
#define XB_TOP      3328
#define XB_TOPGEN   3392
#define XCD_BAR_WORDS 3456
#define XB_SPIN_CAP (1u << 18)

__device__ __forceinline__ unsigned xb_ld(unsigned* p)              { return __hip_atomic_load(p, __ATOMIC_RELAXED, __HIP_MEMORY_SCOPE_AGENT); }
__device__ __forceinline__ unsigned xb_add(unsigned* p, unsigned v) { return __hip_atomic_fetch_add(p, v, __ATOMIC_RELAXED, __HIP_MEMORY_SCOPE_AGENT); }
__device__ __forceinline__ unsigned xb_xcc_id() { return (unsigned)__builtin_amdgcn_s_getreg((3 << 11) | 20) & 0xFu; }
#define XB_SPIN(cond, bar) do { unsigned _sp = 0; while (cond) { __builtin_amdgcn_s_sleep(1); \
    if ((++_sp & 255u) == 0u) { if (xb_ld(&(bar)[XB_TMO])) break; if (_sp > XB_SPIN_CAP) { atomicAdd(&(bar)[XB_TMO], 1u); break; } } } } while (0)

struct XcdBarrier {
    unsigned* bar; unsigned x;
    volatile LAS unsigned* st;
};

__device__ __forceinline__ XcdBarrier xcd_barrier_post(unsigned* bar, volatile LAS unsigned* st) {
    XcdBarrier b; b.bar = bar; b.x = xb_xcc_id(); b.st = st;
    if (threadIdx.x == 0) (void)xb_add(&bar[XB_XCNT(b.x)], 1u);
    return b;
}
__device__ __forceinline__ void xcd_barrier_complete(unsigned* bar, unsigned x, unsigned& nloc, unsigned& nx) {
    const unsigned G = gridDim.x * gridDim.y * gridDim.z;
    unsigned sum, cnt, mine, sp = 0u;
    for (;;) {
        sum = 0u; cnt = 0u; mine = 0u;
#pragma unroll
        for (unsigned j = 0; j < 16; ++j) { const unsigned c = xb_ld(&bar[XB_XCNT(j)]); sum += c; cnt += (c > 0u) ? 1u : 0u; mine = (j == x) ? c : mine; }
        if (sum == G) break;
        __builtin_amdgcn_s_sleep(1);
        if ((++sp & 255u) == 0u) { if (xb_ld(&bar[XB_TMO])) break; if (sp > XB_SPIN_CAP) { atomicAdd(&bar[XB_TMO], 1u); break; } }
    }
    nloc = mine > 0u ? mine : 1u; nx = cnt > 0u ? cnt : 1u;
}

__device__ __forceinline__ void xcd_barrier(const XcdBarrier& b) {
    asm volatile("s_waitcnt vmcnt(0)" ::: "memory");
    __syncthreads();
    if (threadIdx.x == 0) {
        unsigned* bar = b.bar;
        __builtin_amdgcn_s_waitcnt(0);
        unsigned nloc = b.st[0], nx = b.st[1];
        if (nloc == 0u) { xcd_barrier_complete(bar, b.x, nloc, nx); b.st[0] = nloc; b.st[1] = nx; }
        const unsigned old = xb_add(&bar[XB_XSUB(b.x)], 1u);
        const unsigned gen = old / nloc;
        if (old + 1u == (gen + 1u) * nloc) {
            __builtin_amdgcn_fence(__ATOMIC_RELEASE, "agent");
            asm volatile("s_waitcnt vmcnt(0)" ::: "memory");
            const unsigned og = xb_add(&bar[XB_TOP], 1u);
            const unsigned tg = og / nx;
            if (og + 1u == (tg + 1u) * nx) xb_add(&bar[XB_TOPGEN], 1u);
            else XB_SPIN(xb_ld(&bar[XB_TOPGEN]) == tg, bar);
            __builtin_amdgcn_fence(__ATOMIC_ACQUIRE, "agent");
            xb_add(&bar[XB_XGEN(b.x)], 1u);
            asm volatile("s_waitcnt vmcnt(0)" ::: "memory");
        } else {
            XB_SPIN(xb_ld(&bar[XB_XGEN(b.x)]) == gen, bar);
            __builtin_amdgcn_fence(__ATOMIC_ACQUIRE, "agent");
            asm volatile("s_waitcnt vmcnt(0)" ::: "memory");
        }
    }
    __syncthreads();
}

#ifndef MK_N_LAUNCHES
#define MK_N_LAUNCHES 1
#endif
#ifndef PROBE_EXTRA_MASK
#define PROBE_EXTRA_MASK 0
#endif
#ifndef PROBE_SUB
#define PROBE_SUB 3
#endif
#ifndef PROBE_TIME_PHASE
#define PROBE_TIME_PHASE -1
#endif
constexpr int CW_TIME = 512;
constexpr int N_PHASES = 11;
constexpr int N_LAUNCHES = MK_N_LAUNCHES;
constexpr int NWAVES = 8;
constexpr int NB = 8, SEQ = 2048, DM = 1024, MTOK = NB * SEQ;
constexpr float LN_EPS = 1e-5f;
constexpr float DN_ALPHA = 1.189207115002721f;
constexpr float LOG2E = 1.4426950408889634f;
constexpr float QSCALE = 0.125f * LOG2E;
constexpr float LAMBDA_INIT = 0.2f;
constexpr int MODS = 6 * DM;

constexpr size_t MiB = 1u << 20;
constexpr size_t WS_CTL = 0, CTL_ZERO_BYTES = 65536;
constexpr size_t WS_MOD = 1 * MiB;
constexpr size_t WS_WQK = 2 * MiB, WS_WV = 6 * MiB, WS_WO = 8 * MiB, WS_WC = 10 * MiB;
constexpr size_t WS_SDN = 1 * MiB + 256 * 1024, WS_SUP = 1 * MiB + 320 * 1024;
constexpr size_t WS_TDN = 16 * MiB, WS_TUP = 32 * MiB;
constexpr size_t WS_IDG = 48 * MiB, WS_CW = 64 * MiB;
constexpr size_t WS_H2 = 80 * MiB;
constexpr size_t WS_P = 176 * MiB;
constexpr size_t WS_F = 112 * MiB;
constexpr int QKP = 2048 + 64, VTP = MTOK + 64;
constexpr size_t WS_XN = 112 * MiB, WS_QK = 144 * MiB, WS_VT = 211 * MiB;
constexpr size_t WS_CC = 112 * MiB, WS_Y = 144 * MiB, WS_ST = 112 * MiB;
constexpr size_t WS_END = 244 * MiB;
constexpr int CW_BAR = 1024;

constexpr int RING_BYTES = 131072;
constexpr int LDSCTL_OFF = RING_BYTES, MISC_OFF = LDSCTL_OFF + 320;
constexpr int LDS_BYTES = 147456;

typedef float f32x16 __attribute__((ext_vector_type(16)));
typedef float f32x2v __attribute__((ext_vector_type(2)));
typedef unsigned u32x2 __attribute__((ext_vector_type(2)));
typedef __bf16 bf16x2_t __attribute__((ext_vector_type(2)));

__device__ __forceinline__ unsigned cvtpk(float lo, float hi) { f32x2v v = {lo, hi}; bf16x2_t b = __builtin_convertvector(v, bf16x2_t); return __builtin_bit_cast(unsigned, b); }
__device__ __forceinline__ float bf_lo(unsigned w) { return __builtin_bit_cast(float, w << 16); }
__device__ __forceinline__ float bf_hi(unsigned w) { return __builtin_bit_cast(float, w & 0xffff0000u); }
__device__ __forceinline__ float wave_sum(float v) {
#pragma unroll
    for (int o = 1; o < 64; o <<= 1) v += __shfl_xor(v, o);
    return v;
}
__device__ __forceinline__ float dot2bf(unsigned w, unsigned x, float acc) { return __builtin_amdgcn_fdot2_f32_bf16(__builtin_bit_cast(bf16x2_t, w), __builtin_bit_cast(bf16x2_t, x), acc, false); }

__device__ __forceinline__ void phase_mod(const float* c, const float* w_ada, const float* b_ada, float* mod, unsigned char* lds, int tid, int lane, int wave) {
    float* sc = (float*)lds;
    float* red = (float*)(lds + 32768);
    bool did = false;
    for (int item = blockIdx.x; item < MODS / 64; item += gridDim.x) {
        if (!did) { for (int i = tid; i < NB * DM; i += 512) { const float v = c[i]; sc[i] = v / (1.f + __expf(-v)); } __syncthreads(); did = true; }
        const int e0 = item * 64, cg = lane & 15, rs = lane >> 4;
        float acc[8][4];
#pragma unroll
        for (int b = 0; b < 8; ++b) { acc[b][0] = 0.f; acc[b][1] = 0.f; acc[b][2] = 0.f; acc[b][3] = 0.f; }
#pragma unroll 4
        for (int it = 0; it < 32; ++it) {
            const int d = wave * 128 + it * 4 + rs;
            const f32x4 wv = *(const f32x4*)(w_ada + (size_t)d * MODS + e0 + 4 * cg);
#pragma unroll
            for (int b = 0; b < 8; ++b) { const float s = sc[b * DM + d]; acc[b][0] += s * wv[0]; acc[b][1] += s * wv[1]; acc[b][2] += s * wv[2]; acc[b][3] += s * wv[3]; }
        }
#pragma unroll
        for (int b = 0; b < 8; ++b)
#pragma unroll
            for (int j = 0; j < 4; ++j) { float v = acc[b][j]; v += __shfl_xor(v, 16); v += __shfl_xor(v, 32); if (rs == 0) red[(wave * 8 + b) * 64 + 4 * cg + j] = v; }
        __syncthreads();
        { const int b = tid >> 6, col = tid & 63; float s = b_ada[e0 + col];
#pragma unroll
          for (int w = 0; w < 8; ++w) s += red[(w * 8 + b) * 64 + col];
          mod[b * MODS + e0 + col] = s; }
        __syncthreads();
    }
}

__device__ __forceinline__ void transpose_item(const float* W, int ldw, int col0, int K, bf16* WT, int row_off, float scale, LAS float* scr, int kb, int nb, int lane) {
    const int k0 = 64 * kb, n0 = 32 * nb;
#pragma unroll 8
    for (int i = 0; i < 32; ++i) { const int kk = 2 * i + (lane >> 5); scr[kk * 33 + (lane & 31)] = W[(size_t)(k0 + kk) * ldw + col0 + n0 + (lane & 31)]; }
    LDS_WAIT(); asm volatile("" ::: "memory");
    const int c = lane & 7;
#pragma unroll
    for (int j = 0; j < 4; ++j) { const int n = (lane >> 3) + 8 * j; const LAS float* s = scr + (8 * c) * 33 + n;
        v4u o; o.x = cvtpk(s[0 * 33] * scale, s[1 * 33] * scale); o.y = cvtpk(s[2 * 33] * scale, s[3 * 33] * scale); o.z = cvtpk(s[4 * 33] * scale, s[5 * 33] * scale); o.w = cvtpk(s[6 * 33] * scale, s[7 * 33] * scale);
        *(v4u*)(WT + (size_t)(row_off + n0 + n) * K + k0 + 8 * c) = o; }
    LDS_WAIT(); asm volatile("" ::: "memory");
}
__device__ __forceinline__ bf16x8 ld8_f32_bf16(const float* p) {
    const f32x4 a = *(const f32x4*)p, b = *(const f32x4*)(p + 4);
    v4u o; o.x = cvtpk(a[0], a[1]); o.y = cvtpk(a[2], a[3]); o.z = cvtpk(b[0], b[1]); o.w = cvtpk(b[2], b[3]);
    return __builtin_bit_cast(bf16x8, o);
}
__device__ __forceinline__ void wc_item(const float* w_query, const float* sub_keys, bf16* WcT, int item, int lane) {
    const int hp = item >> 6, d0 = (item & 63) * 16, p = hp & 1;
    const int r = lane & 15, kg = lane >> 4;
    bf16x8 a[4];
#pragma unroll
    for (int ks = 0; ks < 4; ++ks) a[ks] = ld8_f32_bf16(w_query + (size_t)(d0 + r) * 2048 + hp * 128 + ks * 32 + 8 * kg);
#pragma unroll
    for (int nt = 0; nt < 8; ++nt) {
        f32x4 acc = {0.f, 0.f, 0.f, 0.f};
#pragma unroll
        for (int ks = 0; ks < 4; ++ks) { const bf16x8 b = ld8_f32_bf16(sub_keys + (size_t)(p * 128 + nt * 16 + r) * 128 + ks * 32 + 8 * kg);
            acc = __builtin_amdgcn_mfma_f32_16x16x32_bf16(a[ks], b, acc, 0, 0, 0); }
        u32x2 o; o.x = cvtpk(acc[0], acc[1]); o.y = cvtpk(acc[2], acc[3]);
        *(u32x2*)(WcT + (size_t)(hp * 128 + nt * 16 + r) * DM + d0 + 4 * kg) = o;
    }
}
struct RowStats { float mean, rstd; };
__device__ __forceinline__ RowStats row_stats(const f32x4 (&v)[4]) {
    float s = 0.f;
#pragma unroll
    for (int j = 0; j < 4; ++j) s += (v[j][0] + v[j][1]) + (v[j][2] + v[j][3]);
    const float mean = wave_sum(s) * (1.f / DM); float s2 = 0.f;
#pragma unroll
    for (int j = 0; j < 4; ++j) { const f32x4 d = v[j] - mean; s2 += (d[0] * d[0] + d[1] * d[1]) + (d[2] * d[2] + d[3] * d[3]); }
    RowStats r; r.mean = mean; r.rstd = 1.f / sqrtf(wave_sum(s2) * (1.f / DM) + LN_EPS); return r;
}
__device__ __forceinline__ void phase_prologue(const float* const* in, unsigned char* ws, LAS unsigned char* lds, int lane, int wave) {
    const float* x = in[0]; const float* w_in = in[4]; const float* w_out = in[5]; const float* w_query = in[15]; const float* sub_keys = in[16];
    const float* mod = (const float*)(ws + WS_MOD);
    LAS float* scr = (LAS float*)(lds + wave * 16384);
    const int gw = blockIdx.x * NWAVES + wave, NGW = gridDim.x * NWAVES;
    for (int it = gw; it < 2048; it += NGW) {
        const int seg = it >> 8, r = it & 255, kb = r >> 4, nb = r & 15;
        switch (seg) {
            case 0: transpose_item(w_in, 3072, 0, DM, (bf16*)(ws + WS_WQK), 0, QSCALE, scr, kb, nb, lane); break;
            case 1: transpose_item(w_in, 3072, 512, DM, (bf16*)(ws + WS_WQK), 512, 1.f, scr, kb, nb, lane); break;
            case 2: transpose_item(w_in, 3072, 1536, DM, (bf16*)(ws + WS_WQK), 1024, QSCALE, scr, kb, nb, lane); break;
            case 3: transpose_item(w_in, 3072, 2048, DM, (bf16*)(ws + WS_WQK), 1536, 1.f, scr, kb, nb, lane); break;
            case 4: transpose_item(w_in, 3072, 1024, DM, (bf16*)(ws + WS_WV), 0, 1.f, scr, kb, nb, lane); break;
            case 5: transpose_item(w_in, 3072, 2560, DM, (bf16*)(ws + WS_WV), 512, 1.f, scr, kb, nb, lane); break;
            case 6: transpose_item(w_out, 1024, 0, DM, (bf16*)(ws + WS_WO), 0, 1.f, scr, kb, nb, lane); break;
            default: transpose_item(w_out, 1024, 512, DM, (bf16*)(ws + WS_WO), 512, 1.f, scr, kb, nb, lane); break;
        }
    }
    for (int it = gw; it < 1024; it += NGW) wc_item(w_query, sub_keys, (bf16*)(ws + WS_WC), it, lane);
    if (gw < MTOK) {
        f32x4 v[4], vn[4];
        { const f32x4* xr = (const f32x4*)(x + (size_t)gw * DM) + lane;
#pragma unroll
          for (int j = 0; j < 4; ++j) v[j] = xr[64 * j]; }
        for (int m = gw; m < MTOK; m += NGW) {
            if (m + NGW < MTOK) { const f32x4* xr = (const f32x4*)(x + (size_t)(m + NGW) * DM) + lane;
#pragma unroll
                for (int j = 0; j < 4; ++j) vn[j] = xr[64 * j]; }
            const int b = m >> 11; const float* sh = mod + b * MODS; const float* scp = sh + DM;
            const RowStats st = row_stats(v);
            u32x2* o8 = (u32x2*)((bf16*)(ws + WS_XN) + (size_t)m * DM) + lane;
#pragma unroll
            for (int j = 0; j < 4; ++j) { const f32x4 s4 = *((const f32x4*)scp + lane + 64 * j), h4 = *((const f32x4*)sh + lane + 64 * j);
                const f32x4 y = (v[j] - st.mean) * st.rstd * (s4 + 1.0f) + h4; u32x2 o; o.x = cvtpk(y[0], y[1]); o.y = cvtpk(y[2], y[3]); o8[64 * j] = o; }
#pragma unroll
            for (int j = 0; j < 4; ++j) v[j] = vn[j];
        }
    }
    f32x4 ev[4], evn[4];
    { const float* src0 = in[17] + (size_t)gw * DM + 16 * lane;
#pragma unroll
      for (int j = 0; j < 4; ++j) ev[j] = *(const f32x4*)(src0 + 4 * j); }
    for (int rr = gw; rr < 32768; rr += NGW) {
        const bool up = rr >= 16384; const int e = up ? rr - 16384 : rr;
        if (rr + NGW < 32768) { const int rn = rr + NGW; const float* srcn = (rn >= 16384 ? in[18] + (size_t)(rn - 16384) * DM : in[17] + (size_t)rn * DM) + 16 * lane;
#pragma unroll
            for (int j = 0; j < 4; ++j) evn[j] = *(const f32x4*)(srcn + 4 * j); }
        f32x4 v[4]; float am = 0.f;
#pragma unroll
        for (int j = 0; j < 4; ++j) { v[j] = ev[j]; ev[j] = evn[j]; am = fmaxf(am, fmaxf(fmaxf(fabsf(v[j][0]), fabsf(v[j][1])), fmaxf(fabsf(v[j][2]), fabsf(v[j][3])))); }
#pragma unroll
        for (int o = 1; o < 64; o <<= 1) am = fmaxf(am, __shfl_xor(am, o));
        const float sc = am > 0.f ? 384.f / am : 1.f;
        v4u q;
        { int w = 0; w = __builtin_amdgcn_cvt_pk_fp8_f32(v[0][0] * sc, v[0][1] * sc, w, false); w = __builtin_amdgcn_cvt_pk_fp8_f32(v[0][2] * sc, v[0][3] * sc, w, true); q.x = (unsigned)w; }
        { int w = 0; w = __builtin_amdgcn_cvt_pk_fp8_f32(v[1][0] * sc, v[1][1] * sc, w, false); w = __builtin_amdgcn_cvt_pk_fp8_f32(v[1][2] * sc, v[1][3] * sc, w, true); q.y = (unsigned)w; }
        { int w = 0; w = __builtin_amdgcn_cvt_pk_fp8_f32(v[2][0] * sc, v[2][1] * sc, w, false); w = __builtin_amdgcn_cvt_pk_fp8_f32(v[2][2] * sc, v[2][3] * sc, w, true); q.z = (unsigned)w; }
        { int w = 0; w = __builtin_amdgcn_cvt_pk_fp8_f32(v[3][0] * sc, v[3][1] * sc, w, false); w = __builtin_amdgcn_cvt_pk_fp8_f32(v[3][2] * sc, v[3][3] * sc, w, true); q.w = (unsigned)w; }
        if (!up) { *(v4u*)(ws + WS_TDN + ((size_t)(lane >> 3) * 16384 + e) * 128 + 16 * (lane & 7)) = q; if (lane == 0) ((float*)(ws + WS_SDN))[e] = am > 0.f ? am * (1.f / 384.f) : 1.f; }
        else { *(v4u*)(ws + WS_TUP + ((size_t)(lane >> 3) * 16384 + e) * 128 + 16 * (lane & 7)) = q; if (lane == 0) ((float*)(ws + WS_SUP))[e] = am > 0.f ? am * (1.f / 384.f) : 1.f; }
    }
}

constexpr int ATT_KSTR = 144, ATT_VSTR = 136;
constexpr int ATT_K0 = 0, ATT_K1 = 64 * ATT_KSTR, ATT_V = 2 * 64 * ATT_KSTR, ATT_BUF = ATT_V + 128 * ATT_VSTR;
constexpr int ATT_TAB = 98304;
constexpr int ATT_RPB_N = 8 * 15 * 31, ATT_T5_N = 4 * 257;
static_assert(2 * ATT_BUF <= 65536 + 8192 && ATT_TAB + (ATT_RPB_N + ATT_T5_N + 4) * 4 <= RING_BYTES, "attention LDS map");

__device__ __forceinline__ int t5_bucket(int rel) {
    const int n = rel < 0 ? -rel : rel; int bucket = rel > 0 ? 16 : 0;
    const float nf = (float)(n < 1 ? 1 : n);
    int large = 8 + (int)(logf(nf / 8.0f) / 2.772588722239781f * 8.0f);
    large = large < 15 ? large : 15;
    return bucket + (n < 8 ? n : large);
}
__device__ __forceinline__ void att_tables(const float* na_rpb, const float* t5_bias, const float* lq1, const float* lk1, const float* lq2, const float* lk2, unsigned char* lds, int tid, int lane, int wave) {
    float* rpbL = (float*)(lds + ATT_TAB); float* t5L = rpbL + ATT_RPB_N; float* lamL = t5L + ATT_T5_N;
    for (int i = tid; i < ATT_RPB_N; i += 512) rpbL[i] = na_rpb[i] * LOG2E;
    for (int i = tid; i < ATT_T5_N; i += 512) { const int h = i / 257, rel = i % 257 - 128; t5L[i] = t5_bias[t5_bucket(rel) * 4 + h] * LOG2E; }
    if (wave == 0) { const float a = wave_sum(lq1[lane] * lk1[lane]), b = wave_sum(lq2[lane] * lk2[lane]); if (lane == 0) lamL[0] = expf(a) - expf(b) + LAMBDA_INIT; }
    __syncthreads();
}

constexpr int NA_KSTR = 144, NA_VSTR = 1168;
static_assert(9 * 64 * NA_KSTR <= ATT_TAB && 64 * NA_VSTR <= ATT_TAB, "NA staging fits below the tables");
__device__ __forceinline__ void na_unit(int unit, const bf16* QK, const bf16* VT, bf16* CC, const float* rpbL, unsigned char* lds, int tid, int lane, int wave) {
    const int rp = unit & 15, h = (unit >> 4) & 7, b = unit >> 7;
    const int r = 2 * rp + (wave >> 2), g = wave & 3;
    const int qi = lane & 15, kg = lane >> 4;
    const int rs = min(max(r - 4, 0), 24), rs_lo = min(max(2 * rp - 4, 0), 24);
    const int nrows = min(9, 32 - rs_lo);
    const int c0 = (g == 0) ? 0 : (g == 1) ? 8 : (g == 2) ? 24 : 32;
    const int qcol = 16 * g + qi, cs = min(max(qcol - 8, 0), 48);
    const size_t tokb = (size_t)b * SEQ;
    v4u st[9];
    { const bf16* kp = QK + (tokb + rs_lo * 64 + (tid >> 3)) * QKP + 512 + h * 64 + (tid & 7) * 8;
#pragma unroll
      for (int j = 0; j < 9; ++j) if (j < nrows) st[j] = *(const v4u*)(kp + (size_t)j * 64 * QKP); }
    const bf16* qp = QK + (tokb + r * 64 + qcol) * QKP + h * 64 + 8 * kg;
    const bf16x8 qf0 = *(const bf16x8*)qp, qf1 = *(const bf16x8*)(qp + 32);
    { unsigned char* kd = lds + (tid >> 3) * NA_KSTR + (tid & 7) * 16;
#pragma unroll
      for (int j = 0; j < 9; ++j) if (j < nrows) *(v4u*)(kd + j * 64 * NA_KSTR) = st[j]; }
    __syncthreads();
    { const bf16* vp = VT + (size_t)(h * 64) * VTP + tokb + rs_lo * 64;
#pragma unroll
      for (int j = 0; j < 9; ++j) { const int c = tid + 512 * j, dh = c / 72, pc = c - dh * 72; if (pc * 8 < nrows * 64) st[j] = *(const v4u*)(vp + (size_t)dh * VTP + pc * 8); } }
    f32x4 s[16];
    { const unsigned char* kb = lds + (((rs - rs_lo) * 64 + c0 + qi) * NA_KSTR) + kg * 16;
#pragma unroll
      for (int t = 0; t < 16; ++t) {
          const int i = t >> 1, half = t & 1;
          const unsigned char* kp = kb + (i * 64 + 16 * half) * NA_KSTR;
          const bf16x8 k0 = *(const bf16x8*)kp, k1 = *(const bf16x8*)(kp + 64);
          f32x4 a = {0.f, 0.f, 0.f, 0.f};
          a = __builtin_amdgcn_mfma_f32_16x16x32_bf16(k0, qf0, a, 0, 0, 0);
          a = __builtin_amdgcn_mfma_f32_16x16x32_bf16(k1, qf1, a, 0, 0, 0);
          s[t] = a;
      } }
    float mx = -INFINITY;
#pragma unroll
    for (int t = 0; t < 16; ++t) {
        const int i = t >> 1, half = t & 1; const float* bp = rpbL + (h * 15 + (rs + i - r + 7)) * 31 + 15;
#pragma unroll
        for (int e = 0; e < 4; ++e) { const int kcol = c0 + 16 * half + 4 * kg + e; const bool valid = (kcol >= cs) && (kcol < cs + 16);
            const int co = min(max(kcol - qcol, -15), 15);
            const float v = valid ? s[t][e] + bp[co] : -INFINITY; s[t][e] = v; mx = fmaxf(mx, v); }
    }
    mx = fmaxf(mx, __shfl_xor(mx, 16)); mx = fmaxf(mx, __shfl_xor(mx, 32));
    float l = 0.f;
#pragma unroll
    for (int t = 0; t < 16; ++t)
#pragma unroll
        for (int e = 0; e < 4; ++e) { const float p = __builtin_amdgcn_exp2f(s[t][e] - mx); s[t][e] = p; l += p; }
    l += __shfl_xor(l, 16); l += __shfl_xor(l, 32);
    __syncthreads();
#pragma unroll
    for (int j = 0; j < 9; ++j) { const int c = tid + 512 * j, dh = c / 72, pc = c - dh * 72; if (pc * 8 < nrows * 64) *(v4u*)(lds + dh * NA_VSTR + pc * 16) = st[j]; }
    __syncthreads();
    f32x4 o[4];
#pragma unroll
    for (int nt = 0; nt < 4; ++nt) o[nt] = (f32x4){0.f, 0.f, 0.f, 0.f};
    { const unsigned char* vb = lds + qi * NA_VSTR + ((rs - rs_lo) * 64 + c0 + 4 * kg) * 2;
#pragma unroll
      for (int kk = 0; kk < 8; ++kk) {
          v4u pw; pw.x = cvtpk(s[2 * kk][0], s[2 * kk][1]); pw.y = cvtpk(s[2 * kk][2], s[2 * kk][3]); pw.z = cvtpk(s[2 * kk + 1][0], s[2 * kk + 1][1]); pw.w = cvtpk(s[2 * kk + 1][2], s[2 * kk + 1][3]);
          const bf16x8 pb = __builtin_bit_cast(bf16x8, pw);
#pragma unroll
          for (int nt = 0; nt < 4; ++nt) {
              const unsigned char* vp = vb + nt * 16 * NA_VSTR + kk * 128;
              const u32x2 lo = *(const u32x2*)vp, hi = *(const u32x2*)(vp + 32);
              v4u aw; aw.x = lo.x; aw.y = lo.y; aw.z = hi.x; aw.w = hi.y;
              o[nt] = __builtin_amdgcn_mfma_f32_16x16x32_bf16(__builtin_bit_cast(bf16x8, aw), pb, o[nt], 0, 0, 0);
          }
      } }
    const float inv = 1.f / l;
    bf16* op = CC + (tokb + r * 64 + qcol) * DM + h * 64 + 4 * kg;
#pragma unroll
    for (int nt = 0; nt < 4; ++nt) { u32x2 w; w.x = cvtpk(o[nt][0] * inv, o[nt][1] * inv); w.y = cvtpk(o[nt][2] * inv, o[nt][3] * inv); *(u32x2*)(op + nt * 16) = w; }
    __syncthreads();
}

__device__ __forceinline__ int crow(int r, int hi) { return (r & 3) + 8 * (r >> 2) + 4 * hi; }

__device__ __forceinline__ void diff_unit(int unit, const bf16* QK, const bf16* VT, bf16* CC, const float* subln, unsigned char* lds, int tid, int lane, int wave) {
    const int qb = unit & 15, h = (unit >> 4) & 3, b = unit >> 6;
    const int mp = wave >> 2, qs = wave & 3, r32 = lane & 31, hi = lane >> 5;
    const size_t tokb = (size_t)b * SEQ;
    const int q0 = qb * 128 + qs * 32;
    const float* t5L = (const float*)(lds + ATT_TAB) + ATT_RPB_N + h * 257 + 128;
    const float lam = ((const float*)(lds + ATT_TAB))[ATT_RPB_N + ATT_T5_N];
    const float cL = t5L[-128], cR = t5L[128];
    bf16x8 qf[4];
    { const bf16* qp = QK + (tokb + q0 + r32) * QKP + 1024 + h * 128 + mp * 64 + 8 * hi;
#pragma unroll
      for (int d0 = 0; d0 < 4; ++d0) qf[d0] = *(const bf16x8*)(qp + d0 * 16); }
    const bf16* ksrc = QK + (tokb + (tid >> 3)) * QKP + 1536 + h * 128 + (tid & 7) * 8;
    const bf16* vsrc = VT + (size_t)(512 + h * 128 + (tid >> 3)) * VTP + tokb + (tid & 7) * 8;
    const int kdst = (tid >> 3) * ATT_KSTR + (tid & 7) * 16, vdst = ATT_V + (tid >> 3) * ATT_VSTR + (tid & 7) * 16;
    v4u sk[2], sv[2];
#define DIFF_LOAD(t) do { sk[0] = *(const v4u*)(ksrc + (size_t)(t) * 64 * QKP); sk[1] = *(const v4u*)(ksrc + (size_t)(t) * 64 * QKP + 64); \
        sv[0] = *(const v4u*)(vsrc + (t) * 64); sv[1] = *(const v4u*)(vsrc + (size_t)64 * VTP + (t) * 64); } while (0)
#define DIFF_STORE(buf) do { unsigned char* bb_ = lds + (buf) * ATT_BUF; *(v4u*)(bb_ + ATT_K0 + kdst) = sk[0]; *(v4u*)(bb_ + ATT_K1 + kdst) = sk[1]; \
        *(u32x2*)(bb_ + vdst) = (u32x2){sv[0].x, sv[0].y}; *(u32x2*)(bb_ + vdst + 8) = (u32x2){sv[0].z, sv[0].w}; \
        *(u32x2*)(bb_ + vdst + 64 * ATT_VSTR) = (u32x2){sv[1].x, sv[1].y}; *(u32x2*)(bb_ + vdst + 64 * ATT_VSTR + 8) = (u32x2){sv[1].z, sv[1].w}; } while (0)
    DIFF_LOAD(0); DIFF_STORE(0); __syncthreads();
    f32x16 o[4];
#pragma unroll
    for (int k = 0; k < 4; ++k)
#pragma unroll
        for (int e = 0; e < 16; ++e) o[k][e] = 0.f;
    float m_run = -1e30f, l_run = 0.f;
    const int qpos = q0 + r32;
    for (int t = 0; t < SEQ / 64; ++t) {
        if (t + 1 < SEQ / 64) DIFF_LOAD(t + 1);
        const unsigned char* bb = lds + (t & 1) * ATT_BUF;
        const unsigned char* kb_ = bb + (mp ? ATT_K1 : ATT_K0) + r32 * ATT_KSTR + hi * 16;
        const bool farL = (64 * t + 63 - q0) <= -91, farR = (64 * t - (q0 + 31)) >= 91;
        const float cinit = farL ? cL : (farR ? cR : 0.f);
        f32x16 p0, p1;
#pragma unroll
        for (int e = 0; e < 16; ++e) { p0[e] = cinit; p1[e] = cinit; }
#pragma unroll
        for (int d0 = 0; d0 < 4; ++d0) {
            const bf16x8 ka = *(const bf16x8*)(kb_ + d0 * 32), kc = *(const bf16x8*)(kb_ + 32 * ATT_KSTR + d0 * 32);
            p0 = __builtin_amdgcn_mfma_f32_32x32x16_bf16(ka, qf[d0], p0, 0, 0, 0);
            p1 = __builtin_amdgcn_mfma_f32_32x32x16_bf16(kc, qf[d0], p1, 0, 0, 0);
        }
        if (!(farL || farR)) {
            const int rel0 = 64 * t - qpos;
#pragma unroll
            for (int e = 0; e < 16; ++e) { const int ra = rel0 + crow(e, hi); const int rb = ra + 32;
                p0[e] += t5L[min(max(ra, -128), 128)]; p1[e] += t5L[min(max(rb, -128), 128)]; }
        }
        float mx = p0[0];
#pragma unroll
        for (int e = 1; e < 16; ++e) mx = fmaxf(mx, p0[e]);
#pragma unroll
        for (int e = 0; e < 16; ++e) mx = fmaxf(mx, p1[e]);
        mx = fmaxf(mx, __shfl_xor(mx, 32));
        const float m_new = fmaxf(m_run, mx), alpha = __builtin_amdgcn_exp2f(m_run - m_new);
        m_run = m_new;
        float ls = 0.f;
#pragma unroll
        for (int e = 0; e < 16; ++e) { p0[e] = __builtin_amdgcn_exp2f(p0[e] - m_new); p1[e] = __builtin_amdgcn_exp2f(p1[e] - m_new); ls += p0[e] + p1[e]; }
        l_run = l_run * alpha + ls;
#pragma unroll
        for (int k = 0; k < 4; ++k)
#pragma unroll
            for (int e = 0; e < 16; ++e) o[k][e] *= alpha;
        bf16x8 pf[4];
        { v4u w;
          w.x = cvtpk(p0[0], p0[1]); w.y = cvtpk(p0[2], p0[3]); w.z = cvtpk(p0[4], p0[5]); w.w = cvtpk(p0[6], p0[7]); pf[0] = __builtin_bit_cast(bf16x8, w);
          w.x = cvtpk(p0[8], p0[9]); w.y = cvtpk(p0[10], p0[11]); w.z = cvtpk(p0[12], p0[13]); w.w = cvtpk(p0[14], p0[15]); pf[1] = __builtin_bit_cast(bf16x8, w);
          w.x = cvtpk(p1[0], p1[1]); w.y = cvtpk(p1[2], p1[3]); w.z = cvtpk(p1[4], p1[5]); w.w = cvtpk(p1[6], p1[7]); pf[2] = __builtin_bit_cast(bf16x8, w);
          w.x = cvtpk(p1[8], p1[9]); w.y = cvtpk(p1[10], p1[11]); w.z = cvtpk(p1[12], p1[13]); w.w = cvtpk(p1[14], p1[15]); pf[3] = __builtin_bit_cast(bf16x8, w); }
        const unsigned char* vb_ = bb + ATT_V + r32 * ATT_VSTR + hi * 8;
#pragma unroll
        for (int blk = 0; blk < 4; ++blk)
#pragma unroll
            for (int ks = 0; ks < 4; ++ks) {
                const unsigned char* vp = vb_ + blk * 32 * ATT_VSTR + ks * 32;
                const u32x2 lo = *(const u32x2*)vp, hv = *(const u32x2*)(vp + 16);
                v4u aw; aw.x = lo.x; aw.y = lo.y; aw.z = hv.x; aw.w = hv.y;
                o[blk] = __builtin_amdgcn_mfma_f32_32x32x16_bf16(__builtin_bit_cast(bf16x8, aw), pf[ks], o[blk], 0, 0, 0);
            }
        if (t + 1 < SEQ / 64) DIFF_STORE((t + 1) & 1);
        __syncthreads();
    }
#undef DIFF_LOAD
#undef DIFF_STORE
    const float ltot = l_run + __shfl_xor(l_run, 32);
    const float inv = (mp ? lam : 1.f) / ltot;
    float* exch = (float*)lds + qs * 4096;
    if (mp == 1) {
#pragma unroll
        for (int k = 0; k < 4; ++k)
#pragma unroll
            for (int e = 0; e < 16; ++e) exch[(k * 16 + e) * 64 + lane] = o[k][e] * inv;
    }
    __syncthreads();
    if (mp == 0) {
        float ss = 0.f;
#pragma unroll
        for (int k = 0; k < 4; ++k)
#pragma unroll
            for (int e = 0; e < 16; ++e) { const float d = o[k][e] * inv - exch[(k * 16 + e) * 64 + lane]; o[k][e] = d; ss += d * d; }
        ss += __shfl_xor(ss, 32);
        const float rn = (1.0f - LAMBDA_INIT) / sqrtf(ss * (1.f / 128.f) + LN_EPS);
        bf16* op = CC + (tokb + q0 + r32) * DM + 512 + h * 128 + 4 * hi;
#pragma unroll
        for (int k = 0; k < 4; ++k)
#pragma unroll
            for (int g4 = 0; g4 < 4; ++g4) { const int dv = k * 32 + 8 * g4 + 4 * hi; const f32x4 sg = *(const f32x4*)(subln + dv);
                u32x2 w; w.x = cvtpk(o[k][4 * g4] * rn * sg[0], o[k][4 * g4 + 1] * rn * sg[1]); w.y = cvtpk(o[k][4 * g4 + 2] * rn * sg[2], o[k][4 * g4 + 3] * rn * sg[3]);
                *(u32x2*)(op + k * 32 + 8 * g4) = w; }
    }
    __syncthreads();
}

__device__ __forceinline__ void phase_attention(const float* const* in, unsigned char* ws, unsigned char* lds, int tid, int lane, int wave, int sub) {
    const bf16* QK = (const bf16*)(ws + WS_QK); const bf16* VT = (const bf16*)(ws + WS_VT); bf16* CC = (bf16*)(ws + WS_CC);
    att_tables(in[6], in[7], in[8], in[9], in[10], in[11], lds, tid, lane, wave);
    const bool xmap = (gridDim.x == 256);
    if (sub & 1) {
        if (xmap) { const int x = blockIdx.x & 7, rk = blockIdx.x >> 3;
            for (int k = 0; k < 2; ++k) { const int idx = rk + 32 * k, pid = x * 4 + (idx >> 4); diff_unit((pid << 4) | (idx & 15), QK, VT, CC, in[12], lds, tid, lane, wave); } }
        else for (int u = blockIdx.x; u < 512; u += gridDim.x) diff_unit(u, QK, VT, CC, in[12], lds, tid, lane, wave);
    }
    const float* rpbL = (const float*)(lds + ATT_TAB);
    if (sub & 2) {
        if (xmap) { const int x = blockIdx.x & 7, rk = blockIdx.x >> 3;
            for (int k = 0; k < 4; ++k) { const int idx = rk + 32 * k; na_unit(((idx >> 4) << 7) | (x << 4) | (idx & 15), QK, VT, CC, rpbL, lds, tid, lane, wave); } }
        else for (int u = blockIdx.x; u < 1024; u += gridDim.x) na_unit(u, QK, VT, CC, rpbL, lds, tid, lane, wave);
    }
}

__device__ __forceinline__ void phase_rows(const float* const* in, unsigned char* ws, float* X1, int lane, int wave) {
    const float* Y = (const float*)(ws + WS_Y); const float* mod = (const float*)(ws + WS_MOD); bf16* H2 = (bf16*)(ws + WS_H2);
    const float* g1 = in[13]; const float* b1 = in[14];
    const int gw = blockIdx.x * NWAVES + wave, NGW = gridDim.x * NWAVES;
    if (gw >= MTOK) return;
    f32x4 v[4], vn[4];
    { const f32x4* yr = (const f32x4*)(Y + (size_t)gw * DM) + lane;
#pragma unroll
      for (int j = 0; j < 4; ++j) v[j] = yr[64 * j]; }
    for (int m = gw; m < MTOK; m += NGW) {
        if (m + NGW < MTOK) { const f32x4* yr = (const f32x4*)(Y + (size_t)(m + NGW) * DM) + lane;
#pragma unroll
            for (int j = 0; j < 4; ++j) vn[j] = yr[64 * j]; }
        const int b = m >> 11; const float* sh = mod + b * MODS + 3 * DM; const float* scp = mod + b * MODS + 4 * DM;
        const RowStats s1 = row_stats(v);
        f32x4* xo = (f32x4*)(X1 + (size_t)m * DM) + lane;
#pragma unroll
        for (int j = 0; j < 4; ++j) { const f32x4 gg = *((const f32x4*)g1 + lane + 64 * j), bb = *((const f32x4*)b1 + lane + 64 * j);
            v[j] = (v[j] - s1.mean) * s1.rstd * gg + bb; xo[64 * j] = v[j]; }
        const RowStats s2 = row_stats(v);
        u32x2* o8 = (u32x2*)(H2 + (size_t)m * DM) + lane;
#pragma unroll
        for (int j = 0; j < 4; ++j) { const f32x4 s4 = *((const f32x4*)scp + lane + 64 * j), h4 = *((const f32x4*)sh + lane + 64 * j);
            const f32x4 y = (v[j] - s2.mean) * s2.rstd * (s4 + 1.0f) + h4; u32x2 o; o.x = cvtpk(y[0], y[1]); o.y = cvtpk(y[2], y[3]); o8[64 * j] = o; }
#pragma unroll
        for (int j = 0; j < 4; ++j) v[j] = vn[j];
    }
}

__device__ __forceinline__ unsigned key_enc(float v, int n) { const unsigned u = __builtin_bit_cast(unsigned, v); const unsigned k = u ^ (((int)u >> 31) | 0x80000000u); return (k & ~127u) | (unsigned)(127 - n); }
__device__ __forceinline__ float key_val(unsigned k) { k &= ~127u; const unsigned u = (k & 0x80000000u) ? (k ^ 0x80000000u) : ~k; return __builtin_bit_cast(float, u); }
__device__ __forceinline__ int key_idx(unsigned k) { return 127 - (int)(k & 127u); }
__device__ __forceinline__ float gelu_erf(float x) { return 0.5f * x * (1.f + erff(x * 0.70710678118654752f)); }

#define TK_SORT16(a) do { unsigned t_; t_ = max(a[0], a[1]); a[1] = min(a[0], a[1]); a[0] = t_; t_ = max(a[2], a[3]); a[3] = min(a[2], a[3]); a[2] = t_; t_ = max(a[0], a[2]); a[2] = min(a[0], a[2]); a[0] = t_; t_ = max(a[1], a[3]); a[3] = min(a[1], a[3]); a[1] = t_; t_ = max(a[1], a[2]); a[2] = min(a[1], a[2]); a[1] = t_; t_ = max(a[4], a[5]); a[5] = min(a[4], a[5]); a[4] = t_; t_ = max(a[6], a[7]); a[7] = min(a[6], a[7]); a[6] = t_; t_ = max(a[4], a[6]); a[6] = min(a[4], a[6]); a[4] = t_; t_ = max(a[5], a[7]); a[7] = min(a[5], a[7]); a[5] = t_; t_ = max(a[5], a[6]); a[6] = min(a[5], a[6]); a[5] = t_; t_ = max(a[0], a[4]); a[4] = min(a[0], a[4]); a[0] = t_; t_ = max(a[2], a[6]); a[6] = min(a[2], a[6]); a[2] = t_; t_ = max(a[2], a[4]); a[4] = min(a[2], a[4]); a[2] = t_; t_ = max(a[1], a[5]); a[5] = min(a[1], a[5]); a[1] = t_; t_ = max(a[3], a[7]); a[7] = min(a[3], a[7]); a[3] = t_; t_ = max(a[3], a[5]); a[5] = min(a[3], a[5]); a[3] = t_; t_ = max(a[1], a[2]); a[2] = min(a[1], a[2]); a[1] = t_; t_ = max(a[3], a[4]); a[4] = min(a[3], a[4]); a[3] = t_; t_ = max(a[5], a[6]); a[6] = min(a[5], a[6]); a[5] = t_; t_ = max(a[8], a[9]); a[9] = min(a[8], a[9]); a[8] = t_; t_ = max(a[10], a[11]); a[11] = min(a[10], a[11]); a[10] = t_; t_ = max(a[8], a[10]); a[10] = min(a[8], a[10]); a[8] = t_; t_ = max(a[9], a[11]); a[11] = min(a[9], a[11]); a[9] = t_; t_ = max(a[9], a[10]); a[10] = min(a[9], a[10]); a[9] = t_; t_ = max(a[12], a[13]); a[13] = min(a[12], a[13]); a[12] = t_; t_ = max(a[14], a[15]); a[15] = min(a[14], a[15]); a[14] = t_; t_ = max(a[12], a[14]); a[14] = min(a[12], a[14]); a[12] = t_; t_ = max(a[13], a[15]); a[15] = min(a[13], a[15]); a[13] = t_; t_ = max(a[13], a[14]); a[14] = min(a[13], a[14]); a[13] = t_; t_ = max(a[8], a[12]); a[12] = min(a[8], a[12]); a[8] = t_; t_ = max(a[10], a[14]); a[14] = min(a[10], a[14]); a[10] = t_; t_ = max(a[10], a[12]); a[12] = min(a[10], a[12]); a[10] = t_; t_ = max(a[9], a[13]); a[13] = min(a[9], a[13]); a[9] = t_; t_ = max(a[11], a[15]); a[15] = min(a[11], a[15]); a[11] = t_; t_ = max(a[11], a[13]); a[13] = min(a[11], a[13]); a[11] = t_; t_ = max(a[9], a[10]); a[10] = min(a[9], a[10]); a[9] = t_; t_ = max(a[11], a[12]); a[12] = min(a[11], a[12]); a[11] = t_; t_ = max(a[13], a[14]); a[14] = min(a[13], a[14]); a[13] = t_; t_ = max(a[0], a[8]); a[8] = min(a[0], a[8]); a[0] = t_; t_ = max(a[4], a[12]); a[12] = min(a[4], a[12]); a[4] = t_; t_ = max(a[4], a[8]); a[8] = min(a[4], a[8]); a[4] = t_; t_ = max(a[2], a[10]); a[10] = min(a[2], a[10]); a[2] = t_; t_ = max(a[6], a[14]); a[14] = min(a[6], a[14]); a[6] = t_; t_ = max(a[6], a[10]); a[10] = min(a[6], a[10]); a[6] = t_; t_ = max(a[2], a[4]); a[4] = min(a[2], a[4]); a[2] = t_; t_ = max(a[6], a[8]); a[8] = min(a[6], a[8]); a[6] = t_; t_ = max(a[10], a[12]); a[12] = min(a[10], a[12]); a[10] = t_; t_ = max(a[1], a[9]); a[9] = min(a[1], a[9]); a[1] = t_; t_ = max(a[5], a[13]); a[13] = min(a[5], a[13]); a[5] = t_; t_ = max(a[5], a[9]); a[9] = min(a[5], a[9]); a[5] = t_; t_ = max(a[3], a[11]); a[11] = min(a[3], a[11]); a[3] = t_; t_ = max(a[7], a[15]); a[15] = min(a[7], a[15]); a[7] = t_; t_ = max(a[7], a[11]); a[11] = min(a[7], a[11]); a[7] = t_; t_ = max(a[3], a[5]); a[5] = min(a[3], a[5]); a[3] = t_; t_ = max(a[7], a[9]); a[9] = min(a[7], a[9]); a[7] = t_; t_ = max(a[11], a[13]); a[13] = min(a[11], a[13]); a[11] = t_; t_ = max(a[1], a[2]); a[2] = min(a[1], a[2]); a[1] = t_; t_ = max(a[3], a[4]); a[4] = min(a[3], a[4]); a[3] = t_; t_ = max(a[5], a[6]); a[6] = min(a[5], a[6]); a[5] = t_; t_ = max(a[7], a[8]); a[8] = min(a[7], a[8]); a[7] = t_; t_ = max(a[9], a[10]); a[10] = min(a[9], a[10]); a[9] = t_; t_ = max(a[11], a[12]); a[12] = min(a[11], a[12]); a[11] = t_; t_ = max(a[13], a[14]); a[14] = min(a[13], a[14]); a[13] = t_; } while (0)
#define TK_CLEAN16(a) do { unsigned t_; t_ = max(a[0], a[8]); a[8] = min(a[0], a[8]); a[0] = t_; t_ = max(a[1], a[9]); a[9] = min(a[1], a[9]); a[1] = t_; t_ = max(a[2], a[10]); a[10] = min(a[2], a[10]); a[2] = t_; t_ = max(a[3], a[11]); a[11] = min(a[3], a[11]); a[3] = t_; t_ = max(a[4], a[12]); a[12] = min(a[4], a[12]); a[4] = t_; t_ = max(a[5], a[13]); a[13] = min(a[5], a[13]); a[5] = t_; t_ = max(a[6], a[14]); a[14] = min(a[6], a[14]); a[6] = t_; t_ = max(a[7], a[15]); a[15] = min(a[7], a[15]); a[7] = t_; t_ = max(a[0], a[4]); a[4] = min(a[0], a[4]); a[0] = t_; t_ = max(a[1], a[5]); a[5] = min(a[1], a[5]); a[1] = t_; t_ = max(a[2], a[6]); a[6] = min(a[2], a[6]); a[2] = t_; t_ = max(a[3], a[7]); a[7] = min(a[3], a[7]); a[3] = t_; t_ = max(a[8], a[12]); a[12] = min(a[8], a[12]); a[8] = t_; t_ = max(a[9], a[13]); a[13] = min(a[9], a[13]); a[9] = t_; t_ = max(a[10], a[14]); a[14] = min(a[10], a[14]); a[10] = t_; t_ = max(a[11], a[15]); a[15] = min(a[11], a[15]); a[11] = t_; t_ = max(a[0], a[2]); a[2] = min(a[0], a[2]); a[0] = t_; t_ = max(a[1], a[3]); a[3] = min(a[1], a[3]); a[1] = t_; t_ = max(a[4], a[6]); a[6] = min(a[4], a[6]); a[4] = t_; t_ = max(a[5], a[7]); a[7] = min(a[5], a[7]); a[5] = t_; t_ = max(a[8], a[10]); a[10] = min(a[8], a[10]); a[8] = t_; t_ = max(a[9], a[11]); a[11] = min(a[9], a[11]); a[9] = t_; t_ = max(a[12], a[14]); a[14] = min(a[12], a[14]); a[12] = t_; t_ = max(a[13], a[15]); a[15] = min(a[13], a[15]); a[13] = t_; t_ = max(a[0], a[1]); a[1] = min(a[0], a[1]); a[0] = t_; t_ = max(a[2], a[3]); a[3] = min(a[2], a[3]); a[2] = t_; t_ = max(a[4], a[5]); a[5] = min(a[4], a[5]); a[4] = t_; t_ = max(a[6], a[7]); a[7] = min(a[6], a[7]); a[6] = t_; t_ = max(a[8], a[9]); a[9] = min(a[8], a[9]); a[8] = t_; t_ = max(a[10], a[11]); a[11] = min(a[10], a[11]); a[10] = t_; t_ = max(a[12], a[13]); a[13] = min(a[12], a[13]); a[12] = t_; t_ = max(a[14], a[15]); a[15] = min(a[14], a[15]); a[14] = t_; } while (0)
#define TK_MERGE16(R, S) do { _Pragma("unroll") for (int i_ = 0; i_ < 16; ++i_) R[i_] = max(R[i_], S[15 - i_]); TK_CLEAN16(R); } while (0)
struct EpiTopK {
    static constexpr bool PERM = false, AFTER_DRAIN = true;
    f32x2v* IDG; int head0;
    __device__ __forceinline__ void fused(pg8::f32x4 (&acc)[2][2][4][2], const pg8::Unit& u, int wr, int wc, int fr, int fq, PG8_LAS unsigned char* lds, int wid, int lane) const {
        const int tid = wid * 64 + lane;
#pragma unroll
        for (int ai = 0; ai < 2; ++ai)
#pragma unroll
            for (int m = 0; m < 4; ++m) { const int row = ai * 128 + wr * 64 + m * 16 + fr;
#pragma unroll
                for (int bj = 0; bj < 2; ++bj)
#pragma unroll
                    for (int n = 0; n < 2; ++n) { const int c = bj * 128 + wc * 32 + n * 16 + 4 * fq; const pg8::f32x4 v = acc[ai][bj][m][n];
                        typedef _Float16 h2 __attribute__((ext_vector_type(2)));
                        const h2 a = {(_Float16)v[0], (_Float16)v[1]}, b = {(_Float16)v[2], (_Float16)v[3]};
                        u32x2 w; w.x = __builtin_bit_cast(unsigned, a); w.y = __builtin_bit_cast(unsigned, b);
                        *(PG8_LAS u32x2*)(lds + row * 512 + (((c >> 3) ^ (row & 31)) << 4) + ((c >> 2) & 1) * 8) = w; } }
        __syncthreads();
        const int tok = tid & 255, p = tid >> 8;
        unsigned tk[16], bb[16];
#define TKF_BATCH(buf, jb) do { const v4u d0_ = *(const PG8_LAS v4u*)(lds + tok * 512 + (((p * 16 + 2 * (jb)) ^ (tok & 31)) << 4)), d1_ = *(const PG8_LAS v4u*)(lds + tok * 512 + (((p * 16 + 2 * (jb) + 1) ^ (tok & 31)) << 4)); \
            const unsigned w_[8] = {d0_.x, d0_.y, d0_.z, d0_.w, d1_.x, d1_.y, d1_.z, d1_.w}; \
            _Pragma("unroll") for (int e = 0; e < 8; ++e) { buf[2 * e] = key_enc((float)__builtin_bit_cast(_Float16, (unsigned short)(w_[e] & 0xffffu)), 16 * (jb) + 2 * e); \
                buf[2 * e + 1] = key_enc((float)__builtin_bit_cast(_Float16, (unsigned short)(w_[e] >> 16)), 16 * (jb) + 2 * e + 1); } \
            TK_SORT16(buf); } while (0)
        TKF_BATCH(tk, 0);
#pragma unroll 1
        for (int jb = 1; jb < 8; ++jb) { TKF_BATCH(bb, jb); TK_MERGE16(tk, bb); }
#undef TKF_BATCH
        __syncthreads();
#pragma unroll
        for (int i = 0; i < 16; ++i) *(PG8_LAS unsigned*)(lds + ((p * 16 + i) * 256 + tok) * 4) = tk[i];
        __syncthreads();
        if (tid < 256) {
            unsigned t0[16], t1[16];
#pragma unroll
            for (int i = 0; i < 16; ++i) { t0[i] = *(const PG8_LAS unsigned*)(lds + (i * 256 + tok) * 4); t1[i] = *(const PG8_LAS unsigned*)(lds + ((16 + i) * 256 + tok) * 4); }
            float bv[16]; int bi[16];
#pragma unroll
            for (int i = 0; i < 16; ++i) { bv[i] = -INFINITY; bi[i] = 0; }
#pragma unroll
            for (int i = 0; i < 16; ++i)
#pragma unroll
                for (int j = 0; j < 16; ++j) if ((i + 1) * (j + 1) <= 16) {
                    float v = key_val(t0[i]) + key_val(t1[j]); int id = key_idx(t0[i]) * 128 + key_idx(t1[j]);
#pragma unroll
                    for (int k = 0; k < 16; ++k) if (k >= (i + 1) * (j + 1) - 1) { const bool c = v > bv[k]; const float nv = c ? bv[k] : v; const int ni = c ? bi[k] : id; bv[k] = c ? v : bv[k]; bi[k] = c ? id : bi[k]; v = nv; id = ni; }
                }
            float sum = 0.f; const float bmax = bv[0];
#pragma unroll
            for (int k = 0; k < 16; ++k) { bv[k] = __expf(bv[k] - bmax); sum += bv[k]; }
            const float rinv = 1.f / sum;
#pragma unroll
            for (int k = 0; k < 16; ++k) { u32x2 pr; pr.x = (unsigned)bi[k]; pr.y = __builtin_bit_cast(unsigned, bv[k] * rinv); *(PG8_LAS u32x2*)(lds + 32768 + tok * 128 + ((k ^ (tok & 15)) << 3)) = pr; }
        }
        __syncthreads();
#pragma unroll
        for (int i = 0; i < 4; ++i) { const int c = tid + 512 * i, tk_ = c >> 3, part = c & 7;
            v4u v = *(const PG8_LAS v4u*)(lds + 32768 + tk_ * 128 + ((part ^ ((tk_ & 15) >> 1)) << 4));
            if (tk_ & 1) { const unsigned a = v.x, b = v.y; v.x = v.z; v.y = v.w; v.z = a; v.w = b; }
            *(v4u*)((unsigned char*)IDG + ((size_t)(u.pm * 256 + tk_) * 128 + (head0 + u.pn) * 16) * 8 + part * 16) = v; }
        __syncthreads();
    }
};

__device__ __forceinline__ float wave_sum_u(float v) {
    v += __builtin_bit_cast(float, __builtin_amdgcn_update_dpp(0, __builtin_bit_cast(int, v), 0xB1, 0xf, 0xf, false));
    v += __builtin_bit_cast(float, __builtin_amdgcn_update_dpp(0, __builtin_bit_cast(int, v), 0x4E, 0xf, 0xf, false));
    v += __builtin_bit_cast(float, __builtin_amdgcn_update_dpp(0, __builtin_bit_cast(int, v), 0x141, 0xf, 0xf, false));
    v += __builtin_bit_cast(float, __builtin_amdgcn_update_dpp(0, __builtin_bit_cast(int, v), 0x140, 0xf, 0xf, false));
    v += __builtin_bit_cast(float, __builtin_amdgcn_update_dpp(0, __builtin_bit_cast(int, v), 0x142, 0xa, 0xf, false));
    v += __builtin_bit_cast(float, __builtin_amdgcn_update_dpp(0, __builtin_bit_cast(int, v), 0x143, 0xc, 0xf, false));
    return __builtin_bit_cast(float, __builtin_amdgcn_readlane(__builtin_bit_cast(int, v), 63));
}
struct SliceMap { int n_x, rank; unsigned own; };
__device__ __forceinline__ SliceMap slice_setup(unsigned* bar, unsigned x, volatile LAS unsigned* st, int tid, bool census) {
    if (census) {
        if (tid == 0) {
            unsigned np = 0, mi = 0, mine = 1;
#pragma unroll
            for (unsigned j = 0; j < 16; ++j) { const unsigned c = xb_ld(&bar[XB_XCNT(j)]); if (c > 0u) { if (j == x) { mi = np; mine = c; } ++np; } }
            if (np == 0u) np = 1u;
            unsigned mask = 0u;
#pragma unroll
            for (unsigned sl = 0; sl < 8; ++sl) if (sl % np == mi) mask |= 1u << sl;
            st[3] = mine; st[4] = mask;
        }
        __syncthreads();
        SliceMap m; m.n_x = (int)st[3]; m.rank = (int)st[2]; m.own = st[4]; return m;
    } else { SliceMap m; m.n_x = gridDim.x / 8; m.rank = blockIdx.x >> 3; m.own = 1u << (blockIdx.x & 7); return m; }
}
__device__ __forceinline__ f32x2v fp8x2(unsigned w, bool hi) { return hi ? __builtin_amdgcn_cvt_pk_f32_fp8((int)w, true) : __builtin_amdgcn_cvt_pk_f32_fp8((int)w, false); }

__device__ __forceinline__ float sum8_dpp(float v) {
    v += __builtin_bit_cast(float, __builtin_amdgcn_update_dpp(0, __builtin_bit_cast(int, v), 0xB1, 0xf, 0xf, false));
    v += __builtin_bit_cast(float, __builtin_amdgcn_update_dpp(0, __builtin_bit_cast(int, v), 0x4E, 0xf, 0xf, false));
    v += __builtin_bit_cast(float, __builtin_amdgcn_update_dpp(0, __builtin_bit_cast(int, v), 0x141, 0xf, 0xf, false));
    return v;
}
__device__ __forceinline__ void phase_down(unsigned char* ws, const SliceMap sm, int lane, int wave) {
    const unsigned* IDX = (const unsigned*)(ws + WS_IDG); const unsigned char* TDN = ws + WS_TDN; const bf16* H2 = (const bf16*)(ws + WS_H2); float* P = (float*)(ws + WS_P);
    const int gwx = sm.rank * NWAVES + wave, nwx = sm.n_x * NWAVES;
    const int eg = lane >> 3, cs = lane & 7;
#define DN_IDS(t_) do { _Pragma("unroll") for (int i = 0; i < 16; ++i) idn[i] = IDX[((size_t)(t_) * 128 + 8 * i + eg) * 2]; } while (0)
#define DN_ROWS(q_) do { _Pragma("unroll") for (int i = 0; i < 16; ++i) q_[i] = *(const v4u*)(tb + (size_t)idn[i] * 128); } while (0)
#define DN_H(h_, t_) do { const v4u* hp_ = (const v4u*)(H2 + (size_t)(t_) * DM + 128 * s + 16 * cs); h_[0] = hp_[0]; h_[1] = hp_[1]; } while (0)
#define DN_COMPUTE(q_, h_, t_) do { \
        f32x2v hx[8]; \
        hx[0] = (f32x2v){bf_lo(h_[0].x), bf_hi(h_[0].x)}; hx[1] = (f32x2v){bf_lo(h_[0].y), bf_hi(h_[0].y)}; hx[2] = (f32x2v){bf_lo(h_[0].z), bf_hi(h_[0].z)}; hx[3] = (f32x2v){bf_lo(h_[0].w), bf_hi(h_[0].w)}; \
        hx[4] = (f32x2v){bf_lo(h_[1].x), bf_hi(h_[1].x)}; hx[5] = (f32x2v){bf_lo(h_[1].y), bf_hi(h_[1].y)}; hx[6] = (f32x2v){bf_lo(h_[1].z), bf_hi(h_[1].z)}; hx[7] = (f32x2v){bf_lo(h_[1].w), bf_hi(h_[1].w)}; \
        float r0 = 0.f, r1 = 0.f; \
        _Pragma("unroll") for (int i = 0; i < 16; ++i) { \
            f32x2v a = fp8x2(q_[i].x, false) * hx[0], b2 = fp8x2(q_[i].x, true) * hx[1]; \
            a += fp8x2(q_[i].y, false) * hx[2]; b2 += fp8x2(q_[i].y, true) * hx[3]; \
            a += fp8x2(q_[i].z, false) * hx[4]; b2 += fp8x2(q_[i].z, true) * hx[5]; \
            a += fp8x2(q_[i].w, false) * hx[6]; b2 += fp8x2(q_[i].w, true) * hx[7]; \
            const float tot = sum8_dpp((a[0] + a[1]) + (b2[0] + b2[1])); \
            if (i < 8) r0 = (cs == i) ? tot : r0; else r1 = (cs == i - 8) ? tot : r1; } \
        float* pp = P + ((size_t)s * MTOK + (t_)) * 128 + 8 * cs + eg; pp[0] = r0; pp[64] = r1; } while (0)
    for (int s = 0; s < 8; ++s) {
        if (!((sm.own >> s) & 1u)) continue;
        const unsigned char* tb = TDN + (size_t)s * 16384 * 128 + 16 * cs;
        int t = gwx; if (t >= MTOK) continue;
        unsigned idn[16]; v4u qa[16], ha[2], hb[2];
        DN_IDS(t); DN_H(ha, t);
        for (;;) {
            DN_ROWS(qa);
            const bool hasB = t + nwx < MTOK;
            if (hasB) { DN_IDS(t + nwx); DN_H(hb, t + nwx); }
            DN_COMPUTE(qa, ha, t);
            if (!hasB) break;
            t += nwx;
            DN_ROWS(qa);
            const bool hasA = t + nwx < MTOK;
            if (hasA) { DN_IDS(t + nwx); DN_H(ha, t + nwx); }
            DN_COMPUTE(qa, hb, t);
            if (!hasA) break;
            t += nwx;
        }
    }
#undef DN_IDS
#undef DN_ROWS
#undef DN_H
#undef DN_COMPUTE
}

__device__ __forceinline__ void phase_combine(unsigned char* ws, int lane, int wave) {
    const f32x2v* IDG = (const f32x2v*)(ws + WS_IDG); unsigned* CWI = (unsigned*)(ws + WS_CW); float* CWW = (float*)(ws + WS_CW + 8 * MiB); const float* P = (const float*)(ws + WS_P);
    const float* SDN = (const float*)(ws + WS_SDN); const float* SUP = (const float*)(ws + WS_SUP);
    const int gw = blockIdx.x * NWAVES + wave, NGW = gridDim.x * NWAVES;
    for (int t = gw; t < MTOK; t += NGW) {
#pragma unroll
        for (int hf = 0; hf < 2; ++hf) {
            const int e = lane + 64 * hf;
            const f32x2v pr = IDG[(size_t)t * 128 + e]; const unsigned id = __builtin_bit_cast(unsigned, pr.x);
            float sum = 0.f;
#pragma unroll
            for (int x = 0; x < 8; ++x) sum += P[((size_t)x * MTOK + t) * 128 + e];
            const float c = pr.y * gelu_erf(sum * SDN[id]) * SUP[id];
            CWI[(size_t)t * 128 + e] = id; CWW[(size_t)t * 128 + e] = c;
        }
    }
}

__device__ __forceinline__ void phase_up(unsigned char* ws, const SliceMap sm, int lane, int wave, int sub) {
    const unsigned* CWI = (const unsigned*)(ws + WS_CW); const float* CWW = (const float*)(ws + WS_CW + 8 * MiB); const unsigned char* TUP = ws + WS_TUP; float* F = (float*)(ws + WS_F);
    const int gwx = sm.rank * NWAVES + wave, nwx = sm.n_x * NWAVES;
    const int eg = lane >> 3, cs = lane & 7;
#define UP_IDS(t_) do { _Pragma("unroll") for (int i = 0; i < 16; ++i) idn[i] = CWI[(size_t)(t_) * 128 + 8 * i + eg]; } while (0)
#define UP_W(w_, t_) do { _Pragma("unroll") for (int i = 0; i < 16; ++i) w_[i] = CWW[(size_t)(t_) * 128 + 8 * i + eg]; } while (0)
#define UP_ROWS(q_) do { _Pragma("unroll") for (int i = 0; i < 16; ++i) q_[i] = *(const v4u*)(tb + (size_t)idn[i] * 128); } while (0)
#define UP_COMPUTE(q_, w_, t_) do { \
        f32x2v acc[8]; \
        _Pragma("unroll") for (int k = 0; k < 8; ++k) acc[k] = (f32x2v){0.f, 0.f}; \
        if (sub == 1) { unsigned xx = 0u; _Pragma("unroll") for (int i = 0; i < 16; ++i) xx ^= q_[i].x ^ q_[i].y ^ q_[i].z ^ q_[i].w ^ __builtin_bit_cast(unsigned, w_[i]); acc[0][0] = __builtin_bit_cast(float, xx); } else \
        _Pragma("unroll") for (int i = 0; i < 16; ++i) { const float w = w_[i]; \
            acc[0] += fp8x2(q_[i].x, false) * w; acc[1] += fp8x2(q_[i].x, true) * w; acc[2] += fp8x2(q_[i].y, false) * w; acc[3] += fp8x2(q_[i].y, true) * w; \
            acc[4] += fp8x2(q_[i].z, false) * w; acc[5] += fp8x2(q_[i].z, true) * w; acc[6] += fp8x2(q_[i].w, false) * w; acc[7] += fp8x2(q_[i].w, true) * w; } \
        _Pragma("unroll") for (int k = 0; k < 8; ++k) \
            _Pragma("unroll") for (int c = 0; c < 2; ++c) { float v = acc[k][c]; v += __shfl_xor(v, 8); v += __shfl_xor(v, 16); v += __shfl_xor(v, 32); acc[k][c] = v; } \
        if (eg == 0) { float* fp = F + (size_t)(t_) * DM + 128 * s + 16 * cs; \
            _Pragma("unroll") for (int k = 0; k < 4; ++k) *(f32x4*)(fp + 4 * k) = (f32x4){acc[2 * k][0], acc[2 * k][1], acc[2 * k + 1][0], acc[2 * k + 1][1]}; } } while (0)
    for (int s = 0; s < 8; ++s) {
        if (!((sm.own >> s) & 1u)) continue;
        const unsigned char* tb = TUP + (size_t)s * 16384 * 128 + 16 * cs;
        int t = gwx; if (t >= MTOK) continue;
        unsigned idn[16]; float wa[16], wb[16]; v4u qa[16];
        UP_IDS(t); UP_W(wa, t);
        for (;;) {
            UP_ROWS(qa);
            const bool hasB = t + nwx < MTOK;
            if (hasB) { UP_IDS(t + nwx); UP_W(wb, t + nwx); }
            UP_COMPUTE(qa, wa, t);
            if (!hasB) break;
            t += nwx;
            UP_ROWS(qa);
            const bool hasA = t + nwx < MTOK;
            if (hasA) { UP_IDS(t + nwx); UP_W(wa, t + nwx); }
            UP_COMPUTE(qa, wb, t);
            if (!hasA) break;
            t += nwx;
        }
    }
#undef UP_IDS
#undef UP_W
#undef UP_ROWS
#undef UP_COMPUTE
}

__device__ __forceinline__ void phase_final(const float* const* in, unsigned char* ws, float* OUT, int lane, int wave) {
    const float pscale = (PROBE_TIME_PHASE >= 0) ? 1.f + sqrtf((float)__hip_atomic_load((const unsigned*)(ws + WS_CTL) + CW_TIME, __ATOMIC_RELAXED, __HIP_MEMORY_SCOPE_AGENT) * 1e-7f) : 1.f;
    const float* F = (const float*)(ws + WS_F); const float* mod = (const float*)(ws + WS_MOD); const float* g2 = in[19]; const float* b2 = in[20];
    const int gw = blockIdx.x * NWAVES + wave, NGW = gridDim.x * NWAVES;
    if (gw >= MTOK) return;
    f32x4 xv[4], fv[4], xn[4], fn[4];
    { const f32x4* xr = (const f32x4*)(OUT + (size_t)gw * DM) + lane; const f32x4* fr = (const f32x4*)(F + (size_t)gw * DM) + lane;
#pragma unroll
      for (int j = 0; j < 4; ++j) { xv[j] = xr[64 * j]; fv[j] = fr[64 * j]; } }
    for (int m = gw; m < MTOK; m += NGW) {
        if (m + NGW < MTOK) { const f32x4* xr = (const f32x4*)(OUT + (size_t)(m + NGW) * DM) + lane; const f32x4* fr = (const f32x4*)(F + (size_t)(m + NGW) * DM) + lane;
#pragma unroll
            for (int j = 0; j < 4; ++j) { xn[j] = xr[64 * j]; fn[j] = fr[64 * j]; } }
        const int b = m >> 11; const float* gf = mod + b * MODS + 5 * DM;
        f32x4* xo = (f32x4*)(OUT + (size_t)m * DM) + lane;
        f32x4 v[4];
#pragma unroll
        for (int j = 0; j < 4; ++j) { const f32x4 gg = *((const f32x4*)gf + lane + 64 * j); v[j] = xv[j] * DN_ALPHA + (gg + 1.0f) * fv[j]; }
        const RowStats st = row_stats(v);
#pragma unroll
        for (int j = 0; j < 4; ++j) { const f32x4 gg = *((const f32x4*)g2 + lane + 64 * j), bb = *((const f32x4*)b2 + lane + 64 * j); xo[64 * j] = ((v[j] - st.mean) * st.rstd * gg + bb) * pscale; }
#pragma unroll
        for (int j = 0; j < 4; ++j) { xv[j] = xn[j]; fv[j] = fn[j]; }
    }
}

struct Args { const float* in[21]; float* out; unsigned char* ws; int ph_lo, ph_hi, sub, pad; };
__global__ void __launch_bounds__(NWAVES * 64, 2) fwd_kernel(Args args) {
    extern __shared__ __attribute__((aligned(16))) unsigned char lds[];
    LAS unsigned char* ldsl = (LAS unsigned char*)lds;
    const int tid = threadIdx.x, lane = tid & 63, wave = __builtin_amdgcn_readfirstlane(tid >> 6);
    const int G = gridDim.x;
    unsigned char* ws = args.ws;
    gu32* ctl = (gu32*)(ws + WS_CTL);
    for (int u = tid; u < (LDS_BYTES - LDSCTL_OFF) / 4; u += NWAVES * 64) ((LAS unsigned*)(ldsl + LDSCTL_OFF))[u] = 0u;
    __syncthreads();
    XcdBarrier bar; bar.bar = (unsigned*)(ctl + CW_BAR); bar.x = 0; bar.st = nullptr;
    volatile LAS unsigned* bst = (volatile LAS unsigned*)(ldsl + MISC_OFF) + 8;
    if (N_LAUNCHES == 1) { bar.bar = (unsigned*)(ctl + CW_BAR); bar.x = xb_xcc_id(); bar.st = bst; if (tid == 0) bst[2] = xb_add(&bar.bar[XB_XCNT(bar.x)], 1u); }
    const int lo = args.ph_lo, hi = args.ph_hi;
#define IN(k) (lo <= (k) && (k) < hi)
    unsigned long long tprobe0 = 0ull;
#define SEAM(k) do { if (IN(k) && IN((k) + 1)) xcd_barrier(bar); \
        if (PROBE_TIME_PHASE == (k) && blockIdx.x == 0 && tid == 0) __hip_atomic_store((unsigned*)(ctl + CW_TIME), (unsigned)(rt() - tprobe0), __ATOMIC_RELAXED, __HIP_MEMORY_SCOPE_AGENT); \
        if (PROBE_TIME_PHASE == (k) + 1 && blockIdx.x == 0 && tid == 0) tprobe0 = rt(); } while (0)
    if (PROBE_TIME_PHASE == 0 && blockIdx.x == 0 && tid == 0) tprobe0 = rt();

    if (IN(0)) { phase_mod(args.in[1], args.in[2], args.in[3], (float*)(ws + WS_MOD), lds, tid, lane, wave); }
    SEAM(0);
    if (IN(1)) { phase_prologue(args.in, ws, ldsl, lane, wave); }
    SEAM(1);
    if (IN(2)) {
        { pg8::Gemm g{(const bf16*)(ws + WS_XN), (const bf16*)(ws + WS_WQK), MTOK, 2048, DM}; pg8::StaticOrder S; S.init(MTOK, 2048, G, (int)blockIdx.x);
          pg8::EpiBf16 E{(bf16*)(ws + WS_QK), QKP};
          pg8::gemm_phase<pg8::EpiBf16, pg8::StaticOrder, true, true>(ldsl, g, S, E); }
        __syncthreads();
        { pg8::Gemm g{(const bf16*)(ws + WS_WV), (const bf16*)(ws + WS_XN), 1024, MTOK, DM}; pg8::StaticOrder S; S.init(1024, MTOK, G, (int)blockIdx.x);
          pg8::EpiBf16 E{(bf16*)(ws + WS_VT), VTP};
          pg8::gemm_phase<pg8::EpiBf16, pg8::StaticOrder, true, true>(ldsl, g, S, E); }
    }
    SEAM(2);
    if (IN(3)) { __syncthreads(); phase_attention(args.in, ws, lds, tid, lane, wave, args.sub); }
    SEAM(3);
    if (IN(4)) {
        pg8::Gemm g{(const bf16*)(ws + WS_CC), (const bf16*)(ws + WS_WO), MTOK, DM, DM}; pg8::StaticOrder S; S.init(MTOK, DM, G, (int)blockIdx.x);
        pg8::EpiY E{args.in[0], (const float*)(ws + WS_MOD) + 2 * DM, MODS, (float*)(ws + WS_Y), DN_ALPHA};
        pg8::gemm_phase<pg8::EpiY, pg8::StaticOrder, true, true>(ldsl, g, S, E);
    }
    SEAM(4);
    if (IN(5)) { phase_rows(args.in, ws, args.out, lane, wave); }
    SEAM(5);
    if (IN(6)) {
        { pg8::Gemm g{(const bf16*)(ws + WS_H2), (const bf16*)(ws + WS_WC), MTOK, 1024, DM}; pg8::StaticOrder S; S.init(MTOK, 1024, G, (int)blockIdx.x);
          EpiTopK E{(f32x2v*)(ws + WS_IDG), 0};
          pg8::gemm_phase<EpiTopK, pg8::StaticOrder, false, true>(ldsl, g, S, E); }
        { pg8::Gemm g{(const bf16*)(ws + WS_H2), (const bf16*)(ws + WS_WC + (size_t)1024 * DM * 2), MTOK, 1024, DM}; pg8::StaticOrder S; S.init(MTOK, 1024, G, (int)blockIdx.x);
          EpiTopK E{(f32x2v*)(ws + WS_IDG), 4};
          pg8::gemm_phase<EpiTopK, pg8::StaticOrder, false, true>(ldsl, g, S, E); }
    }
    SEAM(6);
    if (IN(7)) { const SliceMap sm = slice_setup((unsigned*)(ctl + CW_BAR), bar.x, bst, tid, N_LAUNCHES == 1 && lo == 0 && hi == N_PHASES); phase_down(ws, sm, lane, wave); }
    SEAM(7);
    if (IN(8)) { phase_combine(ws, lane, wave); }
    SEAM(8);
    if (IN(9)) { const SliceMap sm = slice_setup((unsigned*)(ctl + CW_BAR), bar.x, bst, tid, N_LAUNCHES == 1 && lo == 0 && hi == N_PHASES); phase_up(ws, sm, lane, wave, args.sub); }
    SEAM(9);
    if (IN(10)) { phase_final(args.in, ws, args.out, lane, wave); }
#undef IN
#undef SEAM
}

extern "C" void kernel_launch(void* const* d_in, const int* in_sizes, int n_in, void* d_out, int out_size, void* d_ws, size_t ws_size, hipStream_t stream) {
    static int grid = 0;
    if (grid == 0) {
        if (n_in != 21 || out_size != MTOK * DM || ws_size < WS_END) { fprintf(stderr, "kernel_launch: unexpected shapes (n_in %d out %d ws %zu)\n", n_in, out_size, ws_size); grid = -1; return; }
        int dev = 0, cus = 0, per_cu = 0;
        if (hipGetDevice(&dev) != hipSuccess || hipDeviceGetAttribute(&cus, hipDeviceAttributeMultiprocessorCount, dev) != hipSuccess) { grid = -1; return; }
        if (hipFuncSetAttribute((const void*)fwd_kernel, hipFuncAttributeMaxDynamicSharedMemorySize, LDS_BYTES) != hipSuccess) { fprintf(stderr, "kernel_launch: hipFuncSetAttribute failed\n"); grid = -1; return; }
        if (hipOccupancyMaxActiveBlocksPerMultiprocessor(&per_cu, (const void*)fwd_kernel, NWAVES * 64, LDS_BYTES) != hipSuccess || per_cu < 1) { fprintf(stderr, "kernel_launch: occupancy query says %d\n", per_cu); }
        (void)hipGetLastError();
        grid = cus;
    }
    if (grid < 0) return;
    if (hipMemsetAsync((char*)d_ws + WS_CTL, 0, CTL_ZERO_BYTES, stream) != hipSuccess) return;
    Args a{};
    for (int i = 0; i < 21; ++i) a.in[i] = (const float*)d_in[i];
    a.out = (float*)d_out; a.ws = (unsigned char*)d_ws; a.sub = 3;
    if (N_LAUNCHES == 1) { a.ph_lo = 0; a.ph_hi = N_PHASES; hipLaunchKernelGGL(fwd_kernel, dim3(grid), dim3(NWAVES * 64), LDS_BYTES, stream, a); }
    else { for (int p = 0; p < N_PHASES; ++p) { a.ph_lo = p; a.ph_hi = p + 1; hipLaunchKernelGGL(fwd_kernel, dim3(grid), dim3(NWAVES * 64), LDS_BYTES, stream, a); } }
    if (PROBE_EXTRA_MASK) { for (int p = 0; p < N_PHASES; ++p) if ((PROBE_EXTRA_MASK >> p) & 1) { a.ph_lo = p; a.ph_hi = p + 1; a.sub = PROBE_SUB; hipLaunchKernelGGL(fwd_kernel, dim3(grid), dim3(NWAVES * 64), LDS_BYTES, stream, a); } }
}
```
